# Optimizing an MI355X kernel written in HIP

```python
import math
import jax
import jax.numpy as jnp
from jax import lax
import numpy as np

D_MODEL = 1024
BATCH = 8
SEQ = 2048
DEPTH = 2
DEC_BATCH = 128
DEC_SEQ = 1
PAST_LEN = 16384
PAGE_SIZE = 128

F32 = jnp.float32
EPS = 1e-6
CHUNK = 128
N_EVEN = (DEPTH + 1) // 2
N_ODD = DEPTH // 2
D_FF = 2816
SSD_D_INNER = 2 * D_MODEL
SSD_HEAD_DIM = 64
SSD_HEADS = SSD_D_INNER // SSD_HEAD_DIM
SSD_GROUPS = 4
SSD_D_STATE = 128
SSD_CONV = 4
SSD_CONV_CH = SSD_D_INNER + 2 * SSD_GROUPS * SSD_D_STATE
RET_HEADS = 4
RET_QK = D_MODEL
RET_V = 2 * D_MODEL
RET_DK = RET_QK // RET_HEADS
RET_DV = RET_V // RET_HEADS
ROPE_BASE = 10000.0
AB_SIZES = (SSD_D_INNER, SSD_CONV_CH, SSD_HEADS, RET_QK, RET_QK, RET_V, RET_V)
IN_AB = sum(AB_SIZES)
M_HEADS = 4
M_QK = D_MODEL // 2
M_V = D_MODEL
M_DK = M_QK // M_HEADS
M_DV = M_V // M_HEADS
C_SIZES = (M_QK, M_QK, M_V, M_HEADS, M_HEADS, M_V)
IN_C = sum(C_SIZES)
MEM_LEN = 256
X_HEADS = 4
X_HEAD_DIM = D_MODEL // X_HEADS

kernel_name = 'hybrid_ssd_retention_mlstm_macaron_step'


def _split(a, sizes):
    return jnp.split(a, np.cumsum(sizes)[:-1].tolist(), axis=-1)


def _to_chunks(a, c):
    b, l = a.shape[:2]
    return jnp.moveaxis(a.reshape(b, l // c, c, *a.shape[2:]), 1, 0)


def _from_chunks(a):
    n, b, c = a.shape[:3]
    return jnp.moveaxis(a, 0, 1).reshape(b, n * c, *a.shape[3:])


def group_rms(x, groups):
    shp = x.shape
    xf = x.astype(F32).reshape(*shp[:-1], groups, shp[-1] // groups)
    xf = xf * lax.rsqrt(jnp.mean(xf * xf, axis=-1, keepdims=True) + EPS)
    return xf.reshape(shp).astype(x.dtype)


def rmsnorm(x, g):
    return group_rms(x, 1) * g


def swiglu(x, w_in, w_out):
    g, u = jnp.split(x @ w_in, 2, axis=-1)
    return (jax.nn.silu(g) * u) @ w_out


def rotary(x, pos):
    half = x.shape[-1] // 2
    inv = jnp.exp(-math.log(ROPE_BASE) * jnp.arange(half, dtype=F32) / half)
    ang = pos.astype(F32)[:, None] * inv
    cos = jnp.cos(ang)[None, :, None, :]
    sin = jnp.sin(ang)[None, :, None, :]
    xf = x.astype(F32)
    x1, x2 = xf[..., :half], xf[..., half:]
    return jnp.concatenate([x1 * cos - x2 * sin, x1 * sin + x2 * cos], axis=-1).astype(x.dtype)


def causal_conv(u, buf, w, b):
    l = u.shape[1]
    full = jnp.concatenate([buf.astype(u.dtype), u], axis=1)
    out = b + sum(full[:, j:j + l] * w[j] for j in range(SSD_CONV))
    return out, full[:, l:]


def ssd_scan(x, dt, a, bm, cm, h0):
    bsz, l, nh, hp = x.shape
    g = SSD_GROUPS
    r = nh // g
    ns = bm.shape[-1]
    c = math.gcd(l, CHUNK)
    dt = dt.astype(F32)
    da = (dt * a.astype(F32)).reshape(bsz, l, g, r)
    xdt = x.astype(F32).reshape(bsz, l, g, r, hp) * dt.reshape(bsz, l, g, r)[..., None]
    mask = jnp.tril(jnp.ones((c, c), bool))[None, :, :, None, None]

    def step(h, inp):
        xc, dac, bc, cc = inp
        cs = jnp.cumsum(dac, axis=1)
        seg = cs[:, :, None] - cs[:, None, :]
        decay = jnp.exp(jnp.where(mask, seg, -jnp.inf))
        att = jnp.einsum('btgn,bsgn->btsg', cc, bc)[..., None] * decay
        y = jnp.einsum('btsgr,bsgrp->btgrp', att, xc)
        y = y + jnp.einsum('btgn,bgrpn->btgrp', cc, h) * jnp.exp(cs)[..., None]
        last = cs[:, -1]
        w = jnp.exp(last[:, None] - cs)
        h = h * jnp.exp(last)[..., None, None] + jnp.einsum('bsgr,bsgrp,bsgn->bgrpn', w, xc, bc)
        return h, y

    h_init = h0.astype(F32).reshape(bsz, g, r, hp, ns)
    hT, ys = lax.scan(step, h_init, (_to_chunks(xdt, c), _to_chunks(da, c),
                                     _to_chunks(bm.astype(F32), c), _to_chunks(cm.astype(F32), c)))
    y = _from_chunks(ys).reshape(bsz, l, nh, hp)
    return y.astype(x.dtype), hT.reshape(bsz, nh, hp, ns).astype(h0.dtype)


def retention_scan(q, k, v, s0):
    bsz, l, nh, dk = q.shape
    c = math.gcd(l, CHUNK)
    lg = jnp.log1p(-jnp.exp2(-5.0 - jnp.arange(nh, dtype=F32)))
    idx = jnp.arange(c, dtype=F32)
    diff = idx[:, None] - idx[None, :]
    decay = jnp.exp(jnp.where((diff >= 0)[..., None], diff[..., None] * lg, -jnp.inf))
    inner = jnp.exp((idx[:, None] + 1.0) * lg)
    tail = jnp.exp((c - 1.0 - idx)[:, None] * lg)
    carry_decay = jnp.exp(c * lg)

    def step(s, inp):
        qc, kc, vc = inp
        att = jnp.einsum('bthd,bshd->btsh', qc, kc) * decay
        y = jnp.einsum('btsh,bshe->bthe', att, vc) + jnp.einsum('bthd,bhde->bthe', qc, s) * inner[:, :, None]
        s = s * carry_decay[:, None, None] + jnp.einsum('bshd,sh,bshe->bhde', kc, tail, vc)
        return s, y

    sT, ys = lax.scan(step, s0.astype(F32), (_to_chunks(q.astype(F32), c), _to_chunks(k.astype(F32), c),
                                            _to_chunks(v.astype(F32), c)))
    return _from_chunks(ys).astype(v.dtype), sT.astype(s0.dtype)


def mlstm_scan(q, k, v, i_pre, f_pre, c0, n0, m0):
    bsz, l, nh, dk = q.shape
    c = math.gcd(l, CHUNK)
    mask = jnp.tril(jnp.ones((c, c), bool))[None, :, :, None]
    logf = jax.nn.log_sigmoid(f_pre.astype(F32))

    def step(carry, inp):
        cmat, nvec, m = carry
        qc, kc, vc, ic, lfc = inp
        b = jnp.cumsum(lfc, axis=1)
        g = ic - b
        mt = b + jnp.maximum(m[:, None], lax.cummax(g, axis=1))
        w = jnp.exp(jnp.where(mask, g[:, None] + (b - mt)[:, :, None], -jnp.inf))
        a = jnp.einsum('bthd,bshd->btsh', qc, kc) * w
        inter = jnp.exp(b + m[:, None] - mt)
        num = jnp.einsum('btsh,bshe->bthe', a, vc) + jnp.einsum('bthd,bhde->bthe', qc, cmat) * inter[..., None]
        den = a.sum(axis=2) + jnp.einsum('bthd,bhd->bth', qc, nvec) * inter
        hc = num / jnp.maximum(jnp.abs(den), jnp.exp(-mt))[..., None]
        m_new = mt[:, -1]
        wl = jnp.exp(g + (b[:, -1] - m_new)[:, None])
        dp = jnp.exp(b[:, -1] + m - m_new)
        cmat = cmat * dp[..., None, None] + jnp.einsum('bsh,bshd,bshe->bhde', wl, kc, vc)
        nvec = nvec * dp[..., None] + jnp.einsum('bsh,bshd->bhd', wl, kc)
        return (cmat, nvec, m_new), hc

    init = (c0.astype(F32), n0.astype(F32), m0.astype(F32))
    (cT, nT, mT), hs = lax.scan(step, init, (_to_chunks(q.astype(F32), c), _to_chunks(k.astype(F32), c),
                                             _to_chunks(v.astype(F32), c), _to_chunks(i_pre.astype(F32), c),
                                             _to_chunks(logf, c)))
    return (_from_chunks(hs).astype(v.dtype), cT.astype(c0.dtype), nT.astype(n0.dtype), mT.astype(m0.dtype))


def mixer_ab(h, pos, conv_buf, ssm_h, ret_s, w_in, conv_w, conv_b, dt_bias, a_log, d_skip, ssd_norm, w_out):
    bsz, l, _ = h.shape
    z, xbc, dt_raw, rq, rk, rv, rg = _split(h @ w_in, AB_SIZES)
    xbc, conv_buf = causal_conv(xbc, conv_buf, conv_w, conv_b)
    xbc = jax.nn.silu(xbc)
    xs, bm, cm = _split(xbc, (SSD_D_INNER, SSD_GROUPS * SSD_D_STATE, SSD_GROUPS * SSD_D_STATE))
    xs = xs.reshape(bsz, l, SSD_HEADS, SSD_HEAD_DIM)
    dt = jax.nn.softplus((dt_raw + dt_bias).astype(F32))
    a = -jnp.exp(a_log.astype(F32))
    y, ssm_h = ssd_scan(xs, dt, a, bm.reshape(bsz, l, SSD_GROUPS, SSD_D_STATE),
                        cm.reshape(bsz, l, SSD_GROUPS, SSD_D_STATE), ssm_h)
    y = (y + xs * d_skip[:, None]).reshape(bsz, l, SSD_D_INNER) * jax.nn.silu(z)
    y = group_rms(y, SSD_GROUPS) * ssd_norm
    q = rotary(rq.reshape(bsz, l, RET_HEADS, RET_DK), pos)
    k = rotary(rk.reshape(bsz, l, RET_HEADS, RET_DK), pos) * (RET_DK ** -0.5)
    v = rv.reshape(bsz, l, RET_HEADS, RET_DV)
    r, ret_s = retention_scan(q, k, v, ret_s)
    r = jax.nn.silu(rg) * group_rms(r.reshape(bsz, l, RET_V), RET_HEADS)
    return jnp.concatenate([y, r], axis=-1) @ w_out, conv_buf, ssm_h, ret_s


def mixer_c(h, c0, n0, m0, w_in, i_bias, f_bias, norm_g, w_out):
    bsz, l, _ = h.shape
    q, k, v, ig, fg, o = _split(h @ w_in, C_SIZES)
    q = q.reshape(bsz, l, M_HEADS, M_DK)
    k = k.reshape(bsz, l, M_HEADS, M_DK) * (M_DK ** -0.5)
    v = v.reshape(bsz, l, M_HEADS, M_DV)
    hh, c0, n0, m0 = mlstm_scan(q, k, v, ig + i_bias, fg + f_bias, c0, n0, m0)
    hh = group_rms(hh.reshape(bsz, l, M_V), M_HEADS) * norm_g
    return (jax.nn.sigmoid(o) * hh) @ w_out, c0, n0, m0


def mem_kv(mem, norm_g, w_kv):
    bsz = mem.shape[0]
    k, v = jnp.split(rmsnorm(mem, norm_g) @ w_kv, 2, axis=-1)
    return (k.reshape(bsz, MEM_LEN, X_HEADS, X_HEAD_DIM), v.reshape(bsz, MEM_LEN, X_HEADS, X_HEAD_DIM))


def cross_attn(h, k, v, w_q, w_o):
    bsz, l, _ = h.shape
    q = (h @ w_q).reshape(bsz, l, X_HEADS, X_HEAD_DIM)
    s = jnp.einsum('blhd,bmhd->bhlm', q, k.astype(q.dtype)).astype(F32) * (X_HEAD_DIM ** -0.5)
    p = jax.nn.softmax(s, axis=-1).astype(h.dtype)
    o = jnp.einsum('bhlm,bmhd->blhd', p, v.astype(h.dtype)).reshape(bsz, l, D_MODEL)
    return o @ w_o


def trunk(x, pos, mem_k, mem_v, conv_buf, ssm_h, ret_s, mc, mn, mm, p):
    conv_new, ssm_new, ret_new, mc_new, mn_new, mm_new = [], [], [], [], [], []
    for layer in range(DEPTH):
        x = x + 0.5 * swiglu(rmsnorm(x, p['norm_ffn1'][layer]), p['w_ffn1_in'][layer], p['w_ffn1_out'][layer])
        hn = rmsnorm(x, p['norm_mix'][layer])
        e = layer // 2
        if layer % 2 == 0:
            out, cb, sh, rs = mixer_ab(hn, pos, conv_buf[e], ssm_h[e], ret_s[e], p['w_in_ab'][e],
                                       p['ssd_conv_w'][e], p['ssd_conv_b'][e], p['ssd_dt_bias'][e],
                                       p['ssd_a_log'][e], p['ssd_d'][e], p['ssd_norm'][e], p['w_out_ab'][e])
            conv_new.append(cb)
            ssm_new.append(sh)
            ret_new.append(rs)
        else:
            out, c1, n1, m1 = mixer_c(hn, mc[e], mn[e], mm[e], p['w_in_c'][e], p['mlstm_i_bias'][e],
                                      p['mlstm_f_bias'][e], p['mlstm_norm'][e], p['w_out_c'][e])
            mc_new.append(c1)
            mn_new.append(n1)
            mm_new.append(m1)
        x = x + out
        x = x + cross_attn(rmsnorm(x, p['norm_xattn'][layer]), mem_k[layer], mem_v[layer],
                           p['w_xq'][layer], p['w_xo'][layer])
        x = x + 0.5 * swiglu(rmsnorm(x, p['norm_ffn2'][layer]), p['w_ffn2_in'][layer], p['w_ffn2_out'][layer])
    return (rmsnorm(x, p['norm_final']), jnp.stack(conv_new), jnp.stack(ssm_new), jnp.stack(ret_new),
            jnp.stack(mc_new), jnp.stack(mn_new), jnp.stack(mm_new))


def setup_inputs(seed: int = 0) -> dict:
    key = jax.random.key(seed)
    keys = iter(jax.random.split(key, 48))

    def nrm(shape, scale):
        return jax.random.normal(next(keys), shape, F32) * scale

    def gain(shape):
        return 1.0 + nrm(shape, 0.02)

    dt0 = jnp.exp(jax.random.uniform(next(keys), (N_EVEN, SSD_HEADS), F32,
                                     minval=math.log(1e-3), maxval=math.log(1e-1)))
    return {
        'x_prompt': nrm((BATCH, SEQ, D_MODEL), 1.0),
        'x_sample': nrm((DEC_BATCH, DEC_SEQ, D_MODEL), 1.0),
        'cache_mem_k': nrm((DEPTH, DEC_BATCH, MEM_LEN, X_HEADS, X_HEAD_DIM), 1.0),
        'cache_mem_v': nrm((DEPTH, DEC_BATCH, MEM_LEN, X_HEADS, X_HEAD_DIM), 1.0),
        'state_conv': nrm((N_EVEN, DEC_BATCH, SSD_CONV - 1, SSD_CONV_CH), 1.0),
        'state_ssm': nrm((N_EVEN, DEC_BATCH, SSD_HEADS, SSD_HEAD_DIM, SSD_D_STATE), 0.3),
        'state_ret': nrm((N_EVEN, DEC_BATCH, RET_HEADS, RET_DK, RET_DV), 1.0),
        'state_mlstm_c': nrm((N_ODD, DEC_BATCH, M_HEADS, M_DK, M_DV), 0.3),
        'state_mlstm_n': nrm((N_ODD, DEC_BATCH, M_HEADS, M_DK), 0.3),
        'state_mlstm_m': nrm((N_ODD, DEC_BATCH, M_HEADS), 1.0),
        'mem_prompt': nrm((BATCH, MEM_LEN, D_MODEL), 1.0),
        'norm_ffn1': gain((DEPTH, D_MODEL)),
        'w_ffn1_in': nrm((DEPTH, D_MODEL, 2 * D_FF), D_MODEL ** -0.5),
        'w_ffn1_out': nrm((DEPTH, D_FF, D_MODEL), D_FF ** -0.5),
        'norm_mix': gain((DEPTH, D_MODEL)),
        'w_in_ab': nrm((N_EVEN, D_MODEL, IN_AB), D_MODEL ** -0.5),
        'ssd_conv_w': nrm((N_EVEN, SSD_CONV, SSD_CONV_CH), SSD_CONV ** -0.5),
        'ssd_conv_b': nrm((N_EVEN, SSD_CONV_CH), 0.02),
        'ssd_dt_bias': dt0 + jnp.log(-jnp.expm1(-dt0)),
        'ssd_a_log': jnp.log(jax.random.uniform(next(keys), (N_EVEN, SSD_HEADS), F32, minval=1.0, maxval=16.0)),
        'ssd_d': 1.0 + nrm((N_EVEN, SSD_HEADS), 0.1),
        'ssd_norm': gain((N_EVEN, SSD_D_INNER)),
        'w_out_ab': nrm((N_EVEN, SSD_D_INNER + RET_V, D_MODEL), (SSD_D_INNER + RET_V) ** -0.5),
        'w_in_c': nrm((N_ODD, D_MODEL, IN_C), D_MODEL ** -0.5),
        'mlstm_i_bias': nrm((N_ODD, M_HEADS), 0.5),
        'mlstm_f_bias': jnp.linspace(3.0, 6.0, M_HEADS, dtype=F32)[None] + nrm((N_ODD, M_HEADS), 0.1),
        'mlstm_norm': gain((N_ODD, M_V)),
        'w_out_c': nrm((N_ODD, M_V, D_MODEL), M_V ** -0.5),
        'norm_xattn': gain((DEPTH, D_MODEL)),
        'norm_mem': gain((DEPTH, D_MODEL)),
        'w_xq': nrm((DEPTH, D_MODEL, D_MODEL), D_MODEL ** -0.5),
        'w_xkv': nrm((DEPTH, D_MODEL, 2 * D_MODEL), D_MODEL ** -0.5),
        'w_xo': nrm((DEPTH, D_MODEL, D_MODEL), D_MODEL ** -0.5),
        'norm_ffn2': gain((DEPTH, D_MODEL)),
        'w_ffn2_in': nrm((DEPTH, D_MODEL, 2 * D_FF), D_MODEL ** -0.5),
        'w_ffn2_out': nrm((DEPTH, D_FF, D_MODEL), D_FF ** -0.5),
        'norm_final': gain((D_MODEL,)),
    }


def reference(x_prompt, x_sample, cache_mem_k, cache_mem_v, state_conv, state_ssm, state_ret,
              state_mlstm_c, state_mlstm_n, state_mlstm_m, mem_prompt,
              norm_ffn1, w_ffn1_in, w_ffn1_out, norm_mix, w_in_ab, ssd_conv_w, ssd_conv_b,
              ssd_dt_bias, ssd_a_log, ssd_d, ssd_norm, w_out_ab, w_in_c, mlstm_i_bias, mlstm_f_bias,
              mlstm_norm, w_out_c, norm_xattn, norm_mem, w_xq, w_xkv, w_xo, norm_ffn2, w_ffn2_in,
              w_ffn2_out, norm_final):
    p = dict(norm_ffn1=norm_ffn1, w_ffn1_in=w_ffn1_in, w_ffn1_out=w_ffn1_out, norm_mix=norm_mix,
             w_in_ab=w_in_ab, ssd_conv_w=ssd_conv_w, ssd_conv_b=ssd_conv_b, ssd_dt_bias=ssd_dt_bias,
             ssd_a_log=ssd_a_log, ssd_d=ssd_d, ssd_norm=ssd_norm, w_out_ab=w_out_ab, w_in_c=w_in_c,
             mlstm_i_bias=mlstm_i_bias, mlstm_f_bias=mlstm_f_bias, mlstm_norm=mlstm_norm, w_out_c=w_out_c,
             norm_xattn=norm_xattn, w_xq=w_xq, w_xo=w_xo, norm_ffn2=norm_ffn2, w_ffn2_in=w_ffn2_in,
             w_ffn2_out=w_ffn2_out, norm_final=norm_final)
    dt = x_prompt.dtype
    kv = [mem_kv(mem_prompt, norm_mem[layer], w_xkv[layer]) for layer in range(DEPTH)]
    mem_k_prompt = jnp.stack([pair[0] for pair in kv])
    mem_v_prompt = jnp.stack([pair[1] for pair in kv])
    (y_prompt, conv_p, ssm_p, ret_p, mc_p, mn_p, mm_p) = trunk(
        x_prompt, jnp.arange(SEQ), mem_k_prompt, mem_v_prompt,
        jnp.zeros((N_EVEN, BATCH, SSD_CONV - 1, SSD_CONV_CH), dt),
        jnp.zeros((N_EVEN, BATCH, SSD_HEADS, SSD_HEAD_DIM, SSD_D_STATE), dt),
        jnp.zeros((N_EVEN, BATCH, RET_HEADS, RET_DK, RET_DV), dt),
        jnp.zeros((N_ODD, BATCH, M_HEADS, M_DK, M_DV), dt),
        jnp.zeros((N_ODD, BATCH, M_HEADS, M_DK), dt),
        jnp.zeros((N_ODD, BATCH, M_HEADS), dt), p)
    (y_sample, conv_s, ssm_s, ret_s, mc_s, mn_s, mm_s) = trunk(
        x_sample, PAST_LEN + jnp.arange(DEC_SEQ), cache_mem_k, cache_mem_v,
        state_conv, state_ssm, state_ret, state_mlstm_c, state_mlstm_n, state_mlstm_m, p)
    return (y_prompt, y_sample, mem_k_prompt, mem_v_prompt, conv_p, conv_s, ssm_p, ssm_s,
            ret_p, ret_s, mc_p, mc_s, mn_p, mn_s, mm_p, mm_s)
```

```cpp
#include <hip/hip_runtime.h>
#include <cstdio>
#include <cstdint>
namespace pg8 {
#define PG8_LAS __attribute__((address_space(3)))
typedef unsigned short bf16_t;
typedef short bf16x8 __attribute__((ext_vector_type(8)));
typedef float f32x4 __attribute__((ext_vector_type(4)));
typedef unsigned u32x4 __attribute__((ext_vector_type(4)));
constexpr int BM = 256, BK = 64, HALF = 128, HTB = HALF * BK * 2  , STAGE_BYTES = 8 * HTB, NXCD = 8, WGM = 8;

__host__ __device__ __forceinline__ int lds_byte(int r, int c) { const int st = (r >> 4) * 2 + (c >> 5), rr = r & 15, cc = c & 31, ob = rr * 64 + cc * 2; return st * 1024 + (ob ^ (((ob >> 9) & 1) << 5)); }
__host__ __device__ __forceinline__ void stage_rc(int b, int& R, int& C) { const int st = b / 1024, sb = b % 1024, swz = sb ^ (((sb >> 9) & 1) << 5); R = (st >> 1) * 16 + swz / 64; C = (st & 1) * 32 + (swz % 64) / 2; }
__host__ __device__ __forceinline__ int perm32(int rho) { const int n = rho >> 4, i = rho & 15; return 8 * (i >> 2) + 4 * n + (i & 3); }

struct Unit { int pm, pn; };
struct Gemm { const bf16_t* A; const bf16_t* Bt; int M, N, K; };

struct StaticOrder {
    int nM, nN, nwg, G, c;
    __host__ __device__ void init(int M, int N, int G_, int c_) { nM = M / BM; nN = N / BM; nwg = nM * nN; G = G_; c = c_; }
    __host__ __device__ bool next(int i, Unit& u) const {
        const long L = (long)i * G + c; if (L >= nwg) return false;
        int wgid = (int)L; { const int q = nwg / NXCD, r = nwg % NXCD, xcd = wgid % NXCD, off = wgid / NXCD; wgid = (xcd < r ? xcd * (q + 1) : r * (q + 1) + (xcd - r) * q) + off; }
        const int nig = WGM * nN, gid = wgid / nig, fm = gid * WGM, gsz = (nM - fm) < WGM ? (nM - fm) : WGM;
        u.pm = fm + ((wgid % nig) % gsz); u.pn = (wgid % nig) / gsz; return true;
    }
    __device__ __forceinline__ void a_ready(const Unit&) const {}
    __device__ __forceinline__ void done(const Unit&) const {}
};
__device__ __forceinline__ unsigned cvt_pk_bf16(float lo, float hi) { unsigned r; asm volatile("v_cvt_pk_bf16_f32 %0, %1, %2" : "=v"(r) : "v"(lo), "v"(hi)); return r; }
template <class Epi, class Sched, bool ALIGN_EPI = false, bool SP2 = false>
__device__ __forceinline__ void gemm_phase(PG8_LAS unsigned char* lds, const Gemm g, const Sched& S, const Epi& E) {
    int tid = threadIdx.x; asm volatile("" : "+v"(tid));
    const int wid = __builtin_amdgcn_readfirstlane(tid >> 6), lane = tid & 63, wr = wid >> 2, wc = wid & 3, fr = lane & 15, fq = lane >> 4;
    const int K = g.K, nt = K / BK;
    unsigned voffA[2], voffB[2];
#pragma unroll
    for (int i = 0; i < 2; ++i) { int R, C; stage_rc(tid * 16 + i * 8192, R, C); const int Rb = Epi::PERM ? ((R & ~31) + perm32(R & 31)) : R;
        voffA[i] = (unsigned)(R * K + C) * 2u; voffB[i] = (unsigned)(Rb * K + C) * 2u; }
    const size_t kstep = (size_t)(BK * 2);
    const size_t hstep = (size_t)HALF * K * 2;
    const size_t tstep = 2 * hstep;
    const unsigned ldsw = (unsigned)wid * 1024u;
    const int aoff = lds_byte(wr * 64 + fr, fq * 8), boff = lds_byte(wc * 32 + fr, fq * 8);
#define PG8_SA(b, h) (((b) * 2 + (h)) * HTB)
#define PG8_SB(b, h) ((4 + (b) * 2 + (h)) * HTB)
#define PG8_STAGE(bufoff, gbase, voff) do { _Pragma("unroll") for (int _i = 0; _i < 2; ++_i) \
        __builtin_amdgcn_global_load_lds((const unsigned*)((const char*)(gbase) + (voff)[_i]), (PG8_LAS unsigned*)(lds + (bufoff) + ldsw + _i * 8192), 16, 0, 0); } while (0)
#define PG8_LDA(dst, b, h) do { _Pragma("unroll") for (int m = 0; m < 4; ++m) _Pragma("unroll") for (int k = 0; k < 2; ++k) dst[m][k] = *(const PG8_LAS bf16x8*)(lds + PG8_SA(b, h) + aoff + m * 2048 + k * 1024); } while (0)
#define PG8_LDB(dst, b, h) do { _Pragma("unroll") for (int n = 0; n < 2; ++n) _Pragma("unroll") for (int k = 0; k < 2; ++k) dst[n][k] = *(const PG8_LAS bf16x8*)(lds + PG8_SB(b, h) + boff + n * 2048 + k * 1024); } while (0)
#define PG8_MMA(ai, bj, At, Bt) do { __builtin_amdgcn_s_setprio(1); _Pragma("unroll") for (int m = 0; m < 4; ++m) _Pragma("unroll") for (int n = 0; n < 2; ++n) _Pragma("unroll") for (int k = 0; k < 2; ++k) \
        acc[ai][bj][m][n] = __builtin_amdgcn_mfma_f32_16x16x32_bf16(Bt[n][k], At[m][k], acc[ai][bj][m][n], 0, 0, 0); __builtin_amdgcn_s_setprio(0); } while (0)
#define PG8_WAIT_V(n) asm volatile("s_waitcnt vmcnt(" #n ")" ::: "memory")
#define PG8_WAIT_L(n) asm volatile("s_waitcnt lgkmcnt(" #n ")" ::: "memory")
#define PG8_BAR __builtin_amdgcn_s_barrier()
#define PG8_SCHED __builtin_amdgcn_sched_barrier(0)
    Unit cur, nxt; int ui = 0;
    if (!S.next(0, cur)) return;
    f32x4 acc[2][2][4][2];
#pragma unroll
    for (int a = 0; a < 2; ++a)
#pragma unroll
        for (int b = 0; b < 2; ++b)
#pragma unroll
            for (int m = 0; m < 4; ++m)
#pragma unroll
                for (int n = 0; n < 2; ++n) acc[a][b][m][n] = (f32x4){0.f, 0.f, 0.f, 0.f};
    bf16x8 At[4][2], B0[2][2], B1[2][2];
    const char* cA = (const char*)g.A + (size_t)cur.pm * tstep; const char* cB = (const char*)g.Bt + (size_t)cur.pn * tstep;
    S.a_ready(cur);
    if constexpr (SP2) {
        PG8_STAGE(PG8_SB(0, 0), cB, voffB); PG8_STAGE(PG8_SB(0, 1), cB + hstep, voffB); PG8_STAGE(PG8_SA(0, 0), cA, voffA); PG8_STAGE(PG8_SA(0, 1), cA + hstep, voffA);
        if (wr == 1) PG8_BAR;
        PG8_WAIT_V(2); PG8_BAR;
        PG8_STAGE(PG8_SB(1, 0), cB + kstep, voffB); PG8_STAGE(PG8_SA(1, 0), cA + kstep, voffA); PG8_STAGE(PG8_SB(1, 1), cB + hstep + kstep, voffB);
        PG8_WAIT_V(6); PG8_BAR;
    } else {
        PG8_STAGE(PG8_SB(0, 0), cB, voffB); PG8_STAGE(PG8_SA(0, 0), cA, voffA); PG8_STAGE(PG8_SB(0, 1), cB + hstep, voffB); PG8_STAGE(PG8_SA(0, 1), cA + hstep, voffA);
        if (wr == 1) PG8_BAR;
        PG8_WAIT_V(4); PG8_BAR;
        PG8_STAGE(PG8_SB(1, 0), cB + kstep, voffB); PG8_STAGE(PG8_SA(1, 0), cA + kstep, voffA); PG8_STAGE(PG8_SB(1, 1), cB + hstep + kstep, voffB);
        PG8_WAIT_V(6); PG8_BAR;
    }
    for (;;) {
        const bool has_next = S.next(ui + 1, nxt);
        const char* nA = has_next ? (const char*)g.A + (size_t)nxt.pm * tstep : cA; const char* nB = has_next ? (const char*)g.Bt + (size_t)nxt.pn * tstep : cB;
        for (int t = 0; t < nt; t += 2) {
            const bool last = (t == nt - 2);
            const char* a1 = cA + (size_t)(t + 1) * kstep;
            const char* a2 = last ? nA : cA + (size_t)(t + 2) * kstep; const char* b2 = last ? nB : cB + (size_t)(t + 2) * kstep;
            const char* a3 = a2 + kstep; const char* b3 = b2 + kstep;
            if (last && has_next) S.a_ready(nxt);
            if constexpr (SP2) {
            PG8_LDB(B0, 0, 0); PG8_LDB(B1, 0, 1); PG8_SCHED; PG8_LDA(At, 0, 0); PG8_STAGE(PG8_SA(1, 1), a1 + hstep, voffA);
            PG8_WAIT_V(8); PG8_WAIT_L(0); PG8_BAR; PG8_MMA(0, 0, At, B0); PG8_MMA(0, 1, At, B1); PG8_BAR; PG8_SCHED;
            PG8_LDA(At, 0, 1); PG8_STAGE(PG8_SB(0, 0), b2, voffB); PG8_STAGE(PG8_SB(0, 1), b2 + hstep, voffB); PG8_STAGE(PG8_SA(0, 0), a2, voffA);
            PG8_WAIT_V(8); PG8_WAIT_L(0); PG8_BAR; PG8_MMA(1, 0, At, B0); PG8_MMA(1, 1, At, B1); PG8_BAR; PG8_SCHED;
            if constexpr (Epi::STASH) { int tz = t; asm volatile("" : "+s"(tz)); if (tz == 0) E.stash(lds, cur, wid, lane); }
            PG8_LDB(B0, 1, 0); PG8_LDB(B1, 1, 1); PG8_SCHED; PG8_LDA(At, 1, 0); PG8_STAGE(PG8_SA(0, 1), a2 + hstep, voffA);
            PG8_WAIT_V(8); PG8_WAIT_L(0); PG8_BAR; PG8_MMA(0, 0, At, B0); PG8_MMA(0, 1, At, B1); PG8_BAR; PG8_SCHED;
            PG8_LDA(At, 1, 1); PG8_STAGE(PG8_SB(1, 0), b3, voffB); PG8_STAGE(PG8_SB(1, 1), b3 + hstep, voffB); PG8_STAGE(PG8_SA(1, 0), a3, voffA);
            PG8_WAIT_V(8); PG8_WAIT_L(0); PG8_BAR; PG8_MMA(1, 0, At, B0); PG8_MMA(1, 1, At, B1); PG8_BAR; PG8_SCHED;
            } else {
            PG8_LDB(B0, 0, 0); PG8_SCHED; PG8_LDA(At, 0, 0); PG8_STAGE(PG8_SA(1, 1), a1 + hstep, voffA);
            PG8_WAIT_L(8); PG8_BAR; PG8_WAIT_L(0); PG8_MMA(0, 0, At, B0); PG8_BAR; PG8_SCHED;
            PG8_LDB(B1, 0, 1); PG8_STAGE(PG8_SB(0, 0), b2, voffB);
            PG8_BAR; PG8_WAIT_L(0); PG8_MMA(0, 1, At, B1); PG8_BAR;
            PG8_LDA(At, 0, 1); PG8_STAGE(PG8_SA(0, 0), a2, voffA);
            PG8_BAR; PG8_WAIT_L(0); PG8_MMA(1, 0, At, B0); PG8_BAR; PG8_SCHED;
            PG8_STAGE(PG8_SB(0, 1), b2 + hstep, voffB);
            PG8_WAIT_V(6); PG8_BAR; PG8_MMA(1, 1, At, B1); PG8_BAR;
            PG8_LDB(B0, 1, 0); PG8_SCHED; PG8_LDA(At, 1, 0); PG8_STAGE(PG8_SA(0, 1), a2 + hstep, voffA);
            PG8_WAIT_L(8); PG8_BAR; PG8_WAIT_L(0); PG8_MMA(0, 0, At, B0); PG8_BAR; PG8_SCHED;
            PG8_LDB(B1, 1, 1); PG8_STAGE(PG8_SB(1, 0), b3, voffB);
            PG8_BAR; PG8_WAIT_L(0); PG8_MMA(0, 1, At, B1); PG8_BAR;
            PG8_LDA(At, 1, 1); PG8_STAGE(PG8_SA(1, 0), a3, voffA);
            PG8_BAR; PG8_WAIT_L(0); PG8_MMA(1, 0, At, B0); PG8_BAR; PG8_SCHED;
            PG8_STAGE(PG8_SB(1, 1), b3 + hstep, voffB);
            PG8_WAIT_V(6); PG8_BAR; PG8_MMA(1, 1, At, B1); PG8_BAR;
            }
        }
        if constexpr (ALIGN_EPI) { if (wr == 0) PG8_BAR; }
        if constexpr (!Epi::AFTER_DRAIN) { E(acc, cur, wr, wc, fr, fq, lds); S.done(cur); }
        if (!has_next) break;
#pragma unroll
        for (int a = 0; a < 2; ++a)
#pragma unroll
            for (int b = 0; b < 2; ++b)
#pragma unroll
                for (int m = 0; m < 4; ++m)
#pragma unroll
                    for (int n = 0; n < 2; ++n) acc[a][b][m][n] = (f32x4){0.f, 0.f, 0.f, 0.f};
        cur = nxt; cA = nA; cB = nB; ++ui;
        if constexpr (ALIGN_EPI) { if (wr == 1) PG8_BAR; }
    }
    PG8_WAIT_V(0);
    if constexpr (!ALIGN_EPI) { if (wr == 0) PG8_BAR; }
    PG8_BAR;
    if constexpr (Epi::AFTER_DRAIN) { E.fused(acc, cur, wr, wc, fr, fq, lds, wid, lane); S.done(cur); }
#undef PG8_SA
#undef PG8_SB
#undef PG8_STAGE
#undef PG8_LDA
#undef PG8_LDB
#undef PG8_MMA
#undef PG8_WAIT_V
#undef PG8_WAIT_L
#undef PG8_BAR
#undef PG8_SCHED
}
}

#define LAS __attribute__((address_space(3)))
#define XB_TMO      128
#define XB_XCNT(j)  (256  + 64 * (j))
#define XB_XSUB(j)  (1280 + 64 * (j))
#define XB_XGEN(j)  (2304 + 64 * (j))
#define XB_TOP      3328
#define XB_TOPGEN   3392
#define XCD_BAR_WORDS 3456
#define XB_SPIN_CAP (1u << 18)

__device__ __forceinline__ unsigned xb_ld(unsigned* p)              { return __hip_atomic_load(p, __ATOMIC_RELAXED, __HIP_MEMORY_SCOPE_AGENT); }
__device__ __forceinline__ unsigned xb_add(unsigned* p, unsigned v) { return __hip_atomic_fetch_add(p, v, __ATOMIC_RELAXED, __HIP_MEMORY_SCOPE_AGENT); }
__device__ __forceinline__ unsigned xb_xcc_id() { return (unsigned)__builtin_amdgcn_s_getreg((3 << 11) | 20) & 0xFu; }
#define XB_SPIN(cond, bar) do { unsigned _sp = 0; while (cond) { __builtin_amdgcn_s_sleep(1); \
    if ((++_sp & 255u) == 0u) { if (xb_ld(&(bar)[XB_TMO])) break; if (_sp > XB_SPIN_CAP) { atomicAdd(&(bar)[XB_TMO], 1u); break; } } } } while (0)

struct XcdBarrier {
    unsigned* bar; unsigned x;
    volatile LAS unsigned* st;
};

__device__ __forceinline__ XcdBarrier xcd_barrier_post(unsigned* bar, volatile LAS unsigned* st) {
    XcdBarrier b; b.bar = bar; b.x = xb_xcc_id(); b.st = st;
    if (threadIdx.x == 0) (void)xb_add(&bar[XB_XCNT(b.x)], 1u);
    return b;
}
__device__ __forceinline__ void xcd_barrier_complete(unsigned* bar, unsigned x, unsigned& nloc, unsigned& nx) {
    const unsigned G = gridDim.x * gridDim.y * gridDim.z;
    unsigned sum, cnt, mine, sp = 0u;
    for (;;) {
        sum = 0u; cnt = 0u; mine = 0u;
#pragma unroll
        for (unsigned j = 0; j < 16; ++j) { const unsigned c = xb_ld(&bar[XB_XCNT(j)]); sum += c; cnt += (c > 0u) ? 1u : 0u; mine = (j == x) ? c : mine; }
        if (sum == G) break;
        __builtin_amdgcn_s_sleep(1);
        if ((++sp & 255u) == 0u) { if (xb_ld(&bar[XB_TMO])) break; if (sp > XB_SPIN_CAP) { atomicAdd(&bar[XB_TMO], 1u); break; } }
    }
    nloc = mine > 0u ? mine : 1u; nx = cnt > 0u ? cnt : 1u;
}

__device__ __forceinline__ void xcd_barrier(const XcdBarrier& b) {
    asm volatile("s_waitcnt vmcnt(0)" ::: "memory");
    __syncthreads();
    if (threadIdx.x == 0) {
        unsigned* bar = b.bar;
        __builtin_amdgcn_s_waitcnt(0);
        unsigned nloc = b.st[0], nx = b.st[1];
        if (nloc == 0u) { xcd_barrier_complete(bar, b.x, nloc, nx); b.st[0] = nloc; b.st[1] = nx; }
        const unsigned old = xb_add(&bar[XB_XSUB(b.x)], 1u);
        const unsigned gen = old / nloc;
        if (old + 1u == (gen + 1u) * nloc) {
            __builtin_amdgcn_fence(__ATOMIC_RELEASE, "agent");
            asm volatile("s_waitcnt vmcnt(0)" ::: "memory");
            const unsigned og = xb_add(&bar[XB_TOP], 1u);
            const unsigned tg = og / nx;
            if (og + 1u == (tg + 1u) * nx) xb_add(&bar[XB_TOPGEN], 1u);
            else XB_SPIN(xb_ld(&bar[XB_TOPGEN]) == tg, bar);
            __builtin_amdgcn_fence(__ATOMIC_ACQUIRE, "agent");
            xb_add(&bar[XB_XGEN(b.x)], 1u);
            asm volatile("s_waitcnt vmcnt(0)" ::: "memory");
        } else {
            XB_SPIN(xb_ld(&bar[XB_XGEN(b.x)]) == gen, bar);
            __builtin_amdgcn_fence(__ATOMIC_ACQUIRE, "agent");
            asm volatile("s_waitcnt vmcnt(0)" ::: "memory");
        }
    }
    __syncthreads();
}
namespace mk {
#define GAS __attribute__((address_space(1)))
typedef unsigned short bf16;
typedef short bf16x8 __attribute__((ext_vector_type(8)));
typedef short s16x4 __attribute__((ext_vector_type(4)));
typedef float f32x4 __attribute__((ext_vector_type(4)));
typedef float f32x2 __attribute__((ext_vector_type(2)));
typedef unsigned u32x4 __attribute__((ext_vector_type(4)));
typedef unsigned u32x2 __attribute__((ext_vector_type(2)));
typedef LAS unsigned char* ldsp;

constexpr int D = 1024, FF = 2816, NP = 16384, NS = 128, MR = 16512, MP = 16640, SEQ = 2048;
constexpr int NAB = 11264, NABP = 11520, NC = 3072, NCP = 3328;
constexpr int PZ = 0, PX = 2048, PB = 4096, PC = 4608, PRQ = 5120, PRK = 6144, PRV = 7168, PRG = 9216;
constexpr int CQ = 0, CK = 512, CV = 1024, CO = 2048;
constexpr size_t O_Y = 0, O_MEMK = 16908288, O_MEMV = 21102592, O_CONVP = 25296896, O_CONVS = 25370624, O_SSMP = 26550272, O_SSMS = 28647424,
                 O_RETP = 62201856, O_RETS = 66396160, O_MCP = 133505024, O_MCS = 134553600, O_MNP = 151330816, O_MNS = 151334912, O_MMP = 151400448, O_MMS = 151400480;

constexpr size_t al256(size_t x) { return (x + 255) & ~(size_t)255; }
constexpr size_t WS_CTL = 0, CTL_BYTES = 1u << 20;
constexpr size_t WS_ROT = CTL_BYTES;
constexpr size_t WS_W1IN = WS_ROT + al256((size_t)2049 * 128 * 8);
constexpr size_t SZ_WIN = (size_t)5632 * 1024 * 2, SZ_WOUT = (size_t)1024 * 2816 * 2, SZ_SQ = (size_t)1024 * 1024 * 2;
constexpr size_t WS_W2IN = WS_W1IN + 2 * SZ_WIN;
constexpr size_t WS_W1OUT = WS_W2IN + 2 * SZ_WIN;
constexpr size_t WS_W2OUT = WS_W1OUT + 2 * SZ_WOUT;
constexpr size_t WS_WINAB = WS_W2OUT + 2 * SZ_WOUT;
constexpr size_t WS_WOUTAB = WS_WINAB + (size_t)NABP * 1024 * 2;
constexpr size_t WS_WINC = WS_WOUTAB + (size_t)1024 * 4096 * 2;
constexpr size_t WS_WOUTC = WS_WINC + (size_t)NCP * 1024 * 2;
constexpr size_t WS_WXQ = WS_WOUTC + SZ_SQ;
constexpr size_t WS_WXO = WS_WXQ + 2 * SZ_SQ;
constexpr size_t WS_WXKV = WS_WXO + 2 * SZ_SQ;
constexpr size_t WS_X = WS_WXKV + (size_t)4096 * 1024 * 2;
constexpr size_t WS_XB = WS_X + (size_t)MP * 1024 * 4;
constexpr size_t WS_SLOT = WS_XB + (size_t)MP * 1024 * 2;
constexpr size_t WS_MEMB = WS_SLOT + (size_t)MP * 16 * 4;
constexpr size_t WS_MEMSS = WS_MEMB + (size_t)2048 * 1024 * 2;
constexpr size_t WS_KB = WS_MEMSS + 8192;
constexpr size_t WS_VB = WS_KB + (size_t)2 * 2048 * 1024 * 2;
constexpr size_t WS_R3 = WS_VB + (size_t)2 * 2048 * 1024 * 2;
constexpr size_t SZ_R3 = (size_t)MP * 4096 * 2;
constexpr size_t WS_P = WS_R3 + SZ_R3;
constexpr size_t WS_DT = WS_P + (size_t)MP * NAB * 2;
constexpr size_t WS_HC = WS_DT + (size_t)MP * 32 * 4;
constexpr size_t WS_SC = WS_HC + (size_t)8 * 32 * 16 * 64 * 128 * 2;
constexpr size_t WS_MCH = WS_SC + (size_t)8 * 4 * 16 * 512 * 256 * 2;
constexpr size_t WS_XC = WS_MCH + 4096;
constexpr size_t WS_RSS = WS_XC + (size_t)MP * 3072 * 2;
constexpr size_t WS_SSS = WS_RSS + (size_t)NP * 32 * 4;
constexpr size_t WS_END = WS_SSS + (size_t)NP * 32 * 4;

struct Params { const float* in[37]; float* out; unsigned char* ws; };
constexpr int LDSCTL_OFF = 139264;
constexpr int LDS_INTAB = LDSCTL_OFF + 256;
struct Ctx { ldsp lds; unsigned char* ws; float* out;
    __device__ __forceinline__ const float* in(int i) const {
        unsigned z; asm volatile("s_mov_b32 %0, 0" : "=s"(z));
        const unsigned addr = z + (unsigned)(size_t)(lds + LDS_INTAB) + 8u * (unsigned)i;
        const unsigned long long v = *(const LAS unsigned long long*)(size_t)addr;
        return (const float*)(((unsigned long long)(unsigned)__builtin_amdgcn_readfirstlane((int)(unsigned)(v >> 32)) << 32) | (unsigned long long)(unsigned)__builtin_amdgcn_readfirstlane((int)(unsigned)v));
    } };

__device__ __forceinline__ int opaque_tid() { int t = threadIdx.x; asm volatile("" : "+v"(t)); return t; }
__device__ __forceinline__ float bf2f(unsigned short b) { return __uint_as_float((unsigned)b << 16); }
__device__ __forceinline__ float bflo(unsigned w) { return __uint_as_float(w << 16); }
__device__ __forceinline__ float bfhi(unsigned w) { return __uint_as_float(w & 0xffff0000u); }
__device__ __forceinline__ unsigned pk2(float lo, float hi) { unsigned r; asm("v_cvt_pk_bf16_f32 %0, %1, %2" : "=v"(r) : "v"(lo), "v"(hi)); return r; }
__device__ __forceinline__ float siluf(float x) { return x * __builtin_amdgcn_rcpf(1.f + __expf(-x)); }
__device__ __forceinline__ float sigmf(float x) { return __builtin_amdgcn_rcpf(1.f + __expf(-x)); }
__device__ __forceinline__ float softplusf(float v) { return v > 20.f ? v : log1pf(expf(v)); }
__device__ __forceinline__ float logsigf(float x) { return fminf(x, 0.f) - log1pf(expf(-fabsf(x))); }
__device__ __forceinline__ float wave_sum(float v) {
#pragma unroll
    for (int o = 1; o < 64; o <<= 1) v += __shfl_xor(v, o);
    return v;
}
__device__ __forceinline__ float wave_max(float v) {
#pragma unroll
    for (int o = 1; o < 64; o <<= 1) v = fmaxf(v, __shfl_xor(v, o));
    return v;
}
#define LDSW() asm volatile("s_waitcnt lgkmcnt(0)" ::: "memory")
__device__ __forceinline__ void unpack8(const u32x4 w, float (&v)[8]) {
    v[0] = bflo(w.x); v[1] = bfhi(w.x); v[2] = bflo(w.y); v[3] = bfhi(w.y); v[4] = bflo(w.z); v[5] = bfhi(w.z); v[6] = bflo(w.w); v[7] = bfhi(w.w);
}
__device__ __forceinline__ u32x4 pack8(const float (&v)[8]) { u32x4 w; w.x = pk2(v[0], v[1]); w.y = pk2(v[2], v[3]); w.z = pk2(v[4], v[5]); w.w = pk2(v[6], v[7]); return w; }

__device__ __forceinline__ f32x4 ldnt4(const float* p) { return *(const f32x4*)p; }
__device__ __forceinline__ void stnt4(float* p, f32x4 v) { *(f32x4*)p = v; }

typedef short v4i16_t __attribute__((ext_vector_type(4)));
__device__ __forceinline__ s16x4 tr4(ldsp p) { return __builtin_bit_cast(s16x4, __builtin_amdgcn_ds_read_tr16_b64_v4i16((LAS v4i16_t*)p)); }
__device__ __forceinline__ bf16x8 cat8(s16x4 a, s16x4 b) { bf16x8 r; r[0] = a[0]; r[1] = a[1]; r[2] = a[2]; r[3] = a[3]; r[4] = b[0]; r[5] = b[1]; r[6] = b[2]; r[7] = b[3]; return r; }
__device__ __forceinline__ bf16x8 trfrag(ldsp img, int rs, int k0, int c0, int lane) {
    const int g = lane >> 4, i = lane & 15, q = i >> 2, pp = i & 3;
    ldsp a = img + (k0 + 8 * g + q) * rs + (c0 + 4 * pp) * 2;
    return cat8(tr4(a), tr4(a + 4 * rs));
}
__device__ __forceinline__ bf16x8 trfragp(ldsp img, int rs, int k0, int c0, int lane) {
    const int g = lane >> 4, i = lane & 15, q = i >> 2, pp = i & 3;
    ldsp a = img + (k0 + 4 * g + q) * rs + (c0 + 4 * pp) * 2;
    return cat8(tr4(a), tr4(a + 16 * rs));
}
__device__ __forceinline__ bf16x8 rowfrag(ldsp img, int rs, int r0, int k0, int lane) {
    return *(const LAS bf16x8*)(img + (r0 + (lane & 15)) * rs + (k0 + 8 * (lane >> 4)) * 2);
}
__device__ __forceinline__ bf16x8 gfrag(const bf16* base, size_t ld, int r0, int k0, int lane) {
    return *(const bf16x8*)(base + (size_t)(r0 + (lane & 15)) * ld + k0 + 8 * (lane >> 4));
}
__device__ __forceinline__ f32x4 mfma16(bf16x8 a, bf16x8 b, f32x4 c) { return __builtin_amdgcn_mfma_f32_16x16x32_bf16(a, b, c, 0, 0, 0); }
__device__ __forceinline__ bf16x8 packP(f32x4 a, f32x4 b) {
    u32x4 w; w.x = pk2(a[0], a[1]); w.y = pk2(a[2], a[3]); w.z = pk2(b[0], b[1]); w.w = pk2(b[2], b[3]); return __builtin_bit_cast(bf16x8, w);
}

__device__ __forceinline__ float rstd_of(const float* slot, int row) {
    const f32x4* s = (const f32x4*)(slot + (size_t)row * 16);
    const f32x4 a = (s[0] + s[1]) + (s[2] + s[3]);
    return rsqrtf(((a.x + a.y) + (a.z + a.w)) * (1.0f / 1024.0f) + 1e-6f);
}
__device__ __forceinline__ void rstd8(const float* slot, int row0, int fq, float (&rs)[2][4]) {
    f32x4 q[2][4];
#pragma unroll
    for (int ai = 0; ai < 2; ++ai)
#pragma unroll
        for (int m = 0; m < 4; ++m) q[ai][m] = *(const f32x4*)(slot + (size_t)(row0 + ai * 128 + m * 16) * 16 + 4 * fq);
#pragma unroll
    for (int ai = 0; ai < 2; ++ai)
#pragma unroll
        for (int m = 0; m < 4; ++m) { float s = (q[ai][m].x + q[ai][m].y) + (q[ai][m].z + q[ai][m].w); s += __shfl_xor(s, 16); s += __shfl_xor(s, 32); rs[ai][m] = rsqrtf(s * (1.0f / 1024.0f) + 1e-6f); }
}
constexpr int STASH0 = 131072, STASH1 = 140288;
__device__ __forceinline__ void slot_stash(ldsp lds, const float* slot, int pm, int wid, int) {
    unsigned lane = __builtin_amdgcn_mbcnt_hi(~0u, __builtin_amdgcn_mbcnt_lo(~0u, 0u)); asm volatile("" : "+v"(lane));
    const char* sp = (const char*)(slot + (size_t)pm * 256 * 16) + wid * 2048;
    const int base = wid < 4 ? STASH0 + wid * 2048 : STASH1 + (wid - 4) * 2048;
    __builtin_amdgcn_global_load_lds((const unsigned*)(sp + lane * 16u), (LAS unsigned*)(lds + base), 16, 0, 0);
    __builtin_amdgcn_global_load_lds((const unsigned*)(sp + 1024 + lane * 16u), (LAS unsigned*)(lds + base + 1024), 16, 0, 0);
}
__device__ __forceinline__ void rstd8_lds(ldsp lds, int wr, int fr, int fq, float (&rs)[2][4]) {
    unsigned off = (unsigned)(wr * 4096 + fr * 64 + fq * 16); asm volatile("" : "+v"(off));
    const LAS unsigned char* b = lds + STASH0 + off;
#pragma unroll
    for (int ai = 0; ai < 2; ++ai)
#pragma unroll
        for (int m = 0; m < 4; ++m) {
            const f32x4 q = *(const LAS f32x4*)(b + ai * (STASH1 - STASH0) + m * 1024);
            float s = (q.x + q.y) + (q.z + q.w); s += __shfl_xor(s, 16); s += __shfl_xor(s, 32); rs[ai][m] = rsqrtf(s * (1.0f / 1024.0f) + 1e-6f);
        }
}
struct EpiSwiglu {
    static constexpr bool PERM = true, AFTER_DRAIN = false;
    bf16* H; const float* slot; int skip;
    static constexpr bool STASH = true;
    __device__ __forceinline__ void stash(ldsp lds, const pg8::Unit& u, int wid, int lane) const { slot_stash(lds, slot, u.pm, wid, lane); }
    __device__ __forceinline__ void operator()(const pg8::f32x4 (&acc)[2][2][4][2], const pg8::Unit& u, int wr, int wc, int fr, int fq, ldsp lds) const {
        if (skip) {
            float s = 0.f;
#pragma unroll
            for (int ai = 0; ai < 2; ++ai)
#pragma unroll
                for (int bj = 0; bj < 2; ++bj)
#pragma unroll
                    for (int m = 0; m < 4; ++m)
#pragma unroll
                        for (int n = 0; n < 2; ++n) s += (acc[ai][bj][m][n][0] + acc[ai][bj][m][n][1]) + (acc[ai][bj][m][n][2] + acc[ai][bj][m][n][3]);
            if (s == 123.456f) H[0] = 1;
            return;
        }
        const int row0 = u.pm * 256 + wr * 64 + fr;
        float rs[2][4]; if constexpr (STASH) rstd8_lds(lds, wr, fr, fq, rs); else rstd8(slot, row0, fq, rs);
#pragma unroll
        for (int ai = 0; ai < 2; ++ai)
#pragma unroll
            for (int m = 0; m < 4; ++m) {
                const int row = row0 + ai * 128 + m * 16; const float r = rs[ai][m];
                float o[8];
#pragma unroll
                for (int n = 0; n < 2; ++n)
#pragma unroll
                    for (int e = 0; e < 4; ++e) { const float g = acc[ai][0][m][n][e] * r, uu = acc[ai][1][m][n][e] * r; o[n * 4 + e] = siluf(g) * uu; }
                *(u32x4*)(H + (size_t)row * FF + u.pn * 128 + wc * 32 + fq * 8) = pack8(o);
            }
    }
};
struct EpiResid {
    static constexpr bool PERM = true, AFTER_DRAIN = false;
    const float* Xin32; bf16* XB; float* slot; float scale;
    static constexpr bool STASH = false;
    __device__ __forceinline__ void operator()(const pg8::f32x4 (&acc)[2][2][4][2], const pg8::Unit& u, int wr, int wc, int fr, int fq, ldsp) const {
        const int row0 = u.pm * 256 + wr * 64 + fr, col0 = u.pn * 256 + wc * 32 + fq * 8;
#pragma unroll
        for (int ai = 0; ai < 2; ++ai) {
            u32x4 raw[4][2];
            if (Xin32 == nullptr) {
#pragma unroll
                for (int m = 0; m < 4; ++m)
#pragma unroll
                    for (int bj = 0; bj < 2; ++bj) raw[m][bj] = *(const u32x4*)(XB + (size_t)(row0 + ai * 128 + m * 16) * D + col0 + bj * 128);
            }
#pragma unroll
            for (int m = 0; m < 4; ++m) {
                const int row = row0 + ai * 128 + m * 16; float ss = 0.f;
#pragma unroll
                for (int bj = 0; bj < 2; ++bj) {
                    float x[8];
                    if (Xin32 != nullptr) { const float* xi = Xin32 + (size_t)row * D + col0 + bj * 128; const f32x4 a0 = *(const f32x4*)xi, a1 = *(const f32x4*)(xi + 4);
                        x[0] = a0.x; x[1] = a0.y; x[2] = a0.z; x[3] = a0.w; x[4] = a1.x; x[5] = a1.y; x[6] = a1.z; x[7] = a1.w; }
                    else unpack8(raw[m][bj], x);
#pragma unroll
                    for (int e = 0; e < 4; ++e) { x[e] += scale * acc[ai][bj][m][0][e]; x[4 + e] += scale * acc[ai][bj][m][1][e]; }
                    const u32x4 w = pack8(x);
                    *(u32x4*)(XB + (size_t)row * D + col0 + bj * 128) = w;
                    float y[8]; unpack8(w, y);
#pragma unroll
                    for (int e = 0; e < 8; ++e) ss += y[e] * y[e];
                }
                ss += __shfl_xor(ss, 16); ss += __shfl_xor(ss, 32);
                if (fq == 0) slot[(size_t)row * 16 + u.pn * 4 + wc] = ss;
            }
        }
    }
};
template <bool ST> struct EpiScaleT {
    static constexpr bool PERM = true, AFTER_DRAIN = false;
    bf16* O; int ldo; int nmain; float* side; int side_ld; int side_n; const float* slot; int nt;
    const f32x4* rot; int rot_lo, rot_hi, rot_k;
    static constexpr bool STASH = ST;
    __device__ __forceinline__ void stash(ldsp lds, const pg8::Unit& u, int wid, int lane) const { slot_stash(lds, slot, u.pm, wid, lane); }
    __device__ __forceinline__ void operator()(const pg8::f32x4 (&acc)[2][2][4][2], const pg8::Unit& u, int wr, int wc, int fr, int fq, ldsp lds) const {
        const int row0 = u.pm * 256 + wr * 64 + fr;
        const bool dorot = rot != nullptr && u.pn >= rot_lo && u.pn < rot_hi;
        const float ksc = u.pn >= rot_k ? 0.0625f : 1.0f;
        float rsa[2][4]; if constexpr (ST) rstd8_lds(lds, wr, fr, fq, rsa); else rstd8(slot, row0, fq, rsa);
#pragma unroll
        for (int ai = 0; ai < 2; ++ai)
#pragma unroll
            for (int mp = 0; mp < 4; mp += 2) {
                const float rs[2] = {rsa[ai][mp], rsa[ai][mp + 1]};
                f32x4 rt[2][2][2];
                if (dorot) {
#pragma unroll
                    for (int mm = 0; mm < 2; ++mm) {
                        const int row = row0 + ai * 128 + (mp + mm) * 16; const int pos = row < NP ? (row & (SEQ - 1)) : 2048;
#pragma unroll
                        for (int n = 0; n < 2; ++n) { const f32x4* rp = rot + ((size_t)pos * 128 + wc * 32 + fq * 8 + n * 4) / 2; rt[mm][n][0] = rp[0]; rt[mm][n][1] = rp[1]; }
                    }
                }
#pragma unroll
                for (int mm = 0; mm < 2; ++mm) {
                    const int m = mp + mm, row = row0 + ai * 128 + m * 16; const float r = rs[mm];
                    if (u.pn < nmain) {
                        f32x4 v[2][2];
#pragma unroll
                        for (int bj = 0; bj < 2; ++bj)
#pragma unroll
                            for (int n = 0; n < 2; ++n) v[bj][n] = acc[ai][bj][m][n] * r;
                        if (dorot) {
#pragma unroll
                            for (int n = 0; n < 2; ++n) {
                                const f32x4 cs0 = rt[mm][n][0], cs1 = rt[mm][n][1];
                                const f32x4 c = (f32x4){cs0.x, cs0.z, cs1.x, cs1.z} * ksc, s = (f32x4){cs0.y, cs0.w, cs1.y, cs1.w} * ksc;
                                const f32x4 x1 = v[0][n], x2 = v[1][n];
                                v[0][n] = x1 * c - x2 * s; v[1][n] = x1 * s + x2 * c;
                            }
                        }
#pragma unroll
                        for (int bj = 0; bj < 2; ++bj) {
                            const f32x4 v0 = v[bj][0], v1 = v[bj][1];
                            u32x4 w; w.x = pk2(v0.x, v0.y); w.y = pk2(v0.z, v0.w); w.z = pk2(v1.x, v1.y); w.w = pk2(v1.z, v1.w);
                            u32x4* dst = (u32x4*)(O + (size_t)row * ldo + u.pn * 256 + bj * 128 + wc * 32 + fq * 8);
                            if (nt) __builtin_nontemporal_store(w, dst); else *dst = w;
                        }
                    } else if (wc == 0) {
#pragma unroll
                        for (int n = 0; n < 2; ++n)
#pragma unroll
                            for (int e = 0; e < 4; ++e) { const int c = fq * 8 + n * 4 + e; if (c < side_n) side[(size_t)row * side_ld + c] = acc[ai][0][m][n][e] * r; }
                    }
                }
            }
    }
};
using EpiScale = EpiScaleT<true>;
using EpiScaleG = EpiScaleT<false>;
struct EpiMemKV {
    static constexpr bool PERM = true, AFTER_DRAIN = false;
    float* outk; float* outv; bf16* KB; bf16* VB; const float* memss;
    static constexpr bool STASH = false;
    __device__ __forceinline__ void operator()(const pg8::f32x4 (&acc)[2][2][4][2], const pg8::Unit& u, int wr, int wc, int fr, int fq, ldsp) const {
        const int row0 = u.pm * 256 + wr * 64 + fr;
        const int layer = u.pn >> 3, isv = (u.pn >> 2) & 1, ct = u.pn & 3;
        float* of = (isv ? outv : outk) + (size_t)layer * 2048 * 1024; bf16* ob = (isv ? VB : KB) + (size_t)layer * 2048 * 1024;
#pragma unroll
        for (int ai = 0; ai < 2; ++ai)
#pragma unroll
            for (int m = 0; m < 4; ++m) {
                const int row = row0 + ai * 128 + m * 16; const float r = rsqrtf(memss[row] * (1.0f / 1024.0f) + 1e-6f);
#pragma unroll
                for (int bj = 0; bj < 2; ++bj) {
                    const size_t off = (size_t)row * 1024 + ct * 256 + bj * 128 + wc * 32 + fq * 8;
                    const f32x4 v0 = acc[ai][bj][m][0] * r, v1 = acc[ai][bj][m][1] * r;
                    *(f32x4*)(of + off) = v0; *(f32x4*)(of + off + 4) = v1;
                    u32x4 w; w.x = pk2(v0.x, v0.y); w.y = pk2(v0.z, v0.w); w.z = pk2(v1.x, v1.y); w.w = pk2(v1.z, v1.w);
                    *(u32x4*)(ob + off) = w;
                }
            }
    }
};

struct ThinResid {
    const float* Xin32; bf16* XB; float* slot; float scale;
    __device__ __forceinline__ float operator()(int row, int col, f32x4 acc) const {
        bf16* xb = XB + (size_t)row * D + col;
        f32x4 v;
        if (Xin32 != nullptr) v = *(const f32x4*)(Xin32 + (size_t)row * D + col);
        else { const u32x2 w0 = *(const u32x2*)xb; v = (f32x4){bflo(w0.x), bfhi(w0.x), bflo(w0.y), bfhi(w0.y)}; }
        v += scale * acc;
        u32x2 w; w.x = pk2(v.x, v.y); w.y = pk2(v.z, v.w); *(u32x2*)xb = w;
        const float y0 = bflo(w.x), y1 = bfhi(w.x), y2 = bflo(w.y), y3 = bfhi(w.y);
        return (y0 * y0 + y1 * y1) + (y2 * y2 + y3 * y3);
    }
    __device__ __forceinline__ void fin(int row, int ng, float ss) const { slot[(size_t)row * 16 + ng] = ss; }
};
struct ThinScale {
    bf16* O; const float* slot;
    __device__ __forceinline__ float operator()(int row, int col, f32x4 acc) const {
        const float r = rstd_of(slot, row);
        u32x2 w; w.x = pk2(acc.x * r, acc.y * r); w.y = pk2(acc.z * r, acc.w * r); *(u32x2*)(O + (size_t)row * D + col) = w;
        return 0.f;
    }
    __device__ __forceinline__ void fin(int, int, float) const {}
};
struct ThinScaleLd {
    bf16* O; int ld; const float* slot;
    __device__ __forceinline__ float operator()(int row, int col, f32x4 acc) const {
        const float r = rstd_of(slot, row);
        u32x2 w; w.x = pk2(acc.x * r, acc.y * r); w.y = pk2(acc.z * r, acc.w * r); *(u32x2*)(O + (size_t)row * ld + col) = w;
        return 0.f;
    }
    __device__ __forceinline__ void fin(int, int, float) const {}
};
struct ThinGate {
    float* Gt; const float* slot; int cbase;
    __device__ __forceinline__ float operator()(int row, int col, f32x4 acc) const {
        const int c = col - cbase;
        if (c == 0 || c == 4) { const float r = rstd_of(slot, row); *(f32x4*)(Gt + (size_t)row * 8 + c) = acc * r; }
        return 0.f;
    }
    __device__ __forceinline__ void fin(int, int, float) const {}
};
template <class TE, int NJ = 4>
__device__ __forceinline__ void thin_gemm_rc(ldsp lds, const bf16* A, const bf16* Bt, int K, int row0, int col0, int ng, const TE& E);
template <class TE>
__device__ __forceinline__ void thin_gemm(ldsp lds, const bf16* A, const bf16* Bt, int K, int unit, const TE& E) {
    thin_gemm_rc(lds, A, Bt, K, NP + 16 * (unit & 7), 64 * (unit >> 3), unit >> 3, E);
}
template <class TE, int NJ>
__device__ __forceinline__ void thin_gemm_rc(ldsp lds, const bf16* A, const bf16* Bt, int K, int row0, int col0, int ng, const TE& E) {
    const int tid = opaque_tid(), lane = tid & 63, wave = __builtin_amdgcn_readfirstlane(tid >> 6);
    const int kw = K >> 3, kbeg = wave * kw;
    f32x4 acc[NJ];
#pragma unroll
    for (int j = 0; j < NJ; ++j) acc[j] = (f32x4){0.f, 0.f, 0.f, 0.f};
#pragma unroll 4
    for (int k0 = kbeg; k0 < kbeg + kw; k0 += 32) {
        const bf16x8 Xf = gfrag(A, (size_t)K, row0, k0, lane);
#pragma unroll
        for (int j = 0; j < NJ; ++j) acc[j] = mfma16(gfrag(Bt, (size_t)K, col0 + 16 * j, k0, lane), Xf, acc[j]);
    }
    LAS f32x4* red = (LAS f32x4*)lds; LAS float* SS = (LAS float*)(lds + 32768);
#pragma unroll
    for (int j = 0; j < NJ; ++j) red[(wave * NJ + j) * 64 + lane] = acc[j];
    __syncthreads();
    if (wave < NJ) {
        f32x4 v = red[wave * 64 + lane];
#pragma unroll
        for (int w = 1; w < 8; ++w) v += red[(w * NJ + wave) * 64 + lane];
        float ss = E(row0 + (lane & 15), col0 + 16 * wave + 4 * (lane >> 4), v);
        ss += __shfl_xor(ss, 16); ss += __shfl_xor(ss, 32);
        if (lane < 16) SS[wave * 16 + lane] = ss;
    }
    __syncthreads();
    if (NJ == 4) { if (tid < 16) E.fin(row0 + tid, ng, (SS[tid] + SS[16 + tid]) + (SS[32 + tid] + SS[48 + tid])); }
    __syncthreads();
}

template <class TE>
__device__ __forceinline__ void thin_cols16(ldsp lds, const bf16* A, const bf16* Bt, int K, int row0, int col0, const TE& E) {
    const int tid = opaque_tid(), lane = tid & 63, wave = __builtin_amdgcn_readfirstlane(tid >> 6);
    const int kw = K >> 3, kbeg = wave * kw;
    f32x4 acc[4];
#pragma unroll
    for (int j = 0; j < 4; ++j) acc[j] = (f32x4){0.f, 0.f, 0.f, 0.f};
#pragma unroll 4
    for (int k0 = kbeg; k0 < kbeg + kw; k0 += 32) {
        const bf16x8 Bf = gfrag(Bt, (size_t)K, col0, k0, lane);
#pragma unroll
        for (int j = 0; j < 4; ++j) acc[j] = mfma16(Bf, gfrag(A, (size_t)K, row0 + 16 * j, k0, lane), acc[j]);
    }
    LAS f32x4* red = (LAS f32x4*)lds;
#pragma unroll
    for (int j = 0; j < 4; ++j) red[(wave * 4 + j) * 64 + lane] = acc[j];
    __syncthreads();
    if (wave < 4) {
        f32x4 v = red[wave * 64 + lane];
#pragma unroll
        for (int w = 1; w < 8; ++w) v += red[(w * 4 + wave) * 64 + lane];
        E(row0 + 16 * wave + (lane & 15), col0 + 4 * (lane >> 4), v);
    }
    __syncthreads();
}

template <int MODE> __device__ __forceinline__ int dst_row(int n) {
    if (MODE == 1) return n < 2816 ? ((n >> 7) * 256 + (n & 127)) : (((n - 2816) >> 7) * 256 + 128 + ((n - 2816) & 127));
    if (MODE == 2) return n < 5120 ? n : (n < 5152 ? 11264 + (n - 5120) : n - 32);
    if (MODE == 3) return n < 2048 ? n : (n < 2056 ? 3072 + (n - 2048) : n - 8);
    return n;
}
template <int MODE> __device__ __forceinline__ void tr_load(const float* W, int K, int N, const float* g, int glen, int item, int lane, f32x4 (&v)[16]) {
    const int nblk = (N + 63) >> 6, kb = item / nblk, nb = item - kb * nblk, k0 = 64 * kb, n0 = 64 * nb;
    const int rr = lane >> 4, cc = 4 * (lane & 15);
    const int ncl = (n0 + cc < N) ? n0 + cc : 0;
#pragma unroll
    for (int i = 0; i < 16; ++i) v[i] = *(const f32x4*)(W + (size_t)(k0 + 4 * i + rr) * N + ncl);
    if (g != nullptr && k0 < glen) {
#pragma unroll
        for (int i = 0; i < 16; ++i) v[i] *= g[k0 + 4 * i + rr];
    }
}
template <int MODE> __device__ __forceinline__ void tr_store(int K, int N, bf16* WT, int row_off, LAS float* scr, int item, int lane, const f32x4 (&v)[16]) {
    const int nblk = (N + 63) >> 6, kb = item / nblk, nb = item - kb * nblk, k0 = 64 * kb, n0 = 64 * nb;
    const int rr = lane >> 4, cc = 4 * (lane & 15);
#pragma unroll
    for (int i = 0; i < 16; ++i) { LAS float* d = scr + (4 * i + rr) * 65 + cc; d[0] = v[i].x; d[1] = v[i].y; d[2] = v[i].z; d[3] = v[i].w; }
    LDSW();
    const int c = lane & 7, nl = lane >> 3;
#pragma unroll
    for (int j = 0; j < 8; ++j) {
        const int n = nl + 8 * j; const LAS float* s = scr + (8 * c) * 65 + n;
        u32x4 o; o.x = pk2(s[0 * 65], s[1 * 65]); o.y = pk2(s[2 * 65], s[3 * 65]); o.z = pk2(s[4 * 65], s[5 * 65]); o.w = pk2(s[6 * 65], s[7 * 65]);
        if (n0 + n < N) *(u32x4*)(WT + (size_t)(row_off + dst_row<MODE>(n0 + n)) * K + k0 + 8 * c) = o;
    }
    LDSW();
}
template <int MODE> __device__ __forceinline__ void tr_item2(const float* W, int K, int N, bf16* WT, int row_off, const float* g, int glen, LAS float* scr, int it0, int it1, int ni, int lane) {
    f32x4 va[16], vb[16];
    tr_load<MODE>(W, K, N, g, glen, it0, lane, va);
    if (it1 < ni) tr_load<MODE>(W, K, N, g, glen, it1, lane, vb);
    tr_store<MODE>(K, N, WT, row_off, scr, it0, lane, va);
    if (it1 < ni) tr_store<MODE>(K, N, WT, row_off, scr, it1, lane, vb);
}
template <int SET>
__device__ __forceinline__ void convert_set(const Ctx& p, ldsp lds, int wg, int nwg) {
    const int tid = opaque_tid(), lane = tid & 63, wave = tid >> 6;
    unsigned char* ws = p.ws;
    LAS float* scr = (LAS float*)(lds + wave * 16640);
    const int gw = wg * 8 + wave, NGW = nwg * 8;
#define TR_MAT(MODE, W, K, N, WT, ROFF, GP, GLEN) { const int ni = ((K) / 64) * (((N) + 63) / 64); \
        if constexpr (SET == 0) { for (int it = gw; it < ni; it += 2 * NGW) tr_item2<MODE>((W), (K), (N), (bf16*)(WT), (ROFF), (GP), (GLEN), scr, it, it + NGW, ni, lane); } \
        else { for (int it = gw; it < ni; it += NGW) { f32x4 va[16]; tr_load<MODE>((W), (K), (N), (GP), (GLEN), it, lane, va); tr_store<MODE>((K), (N), (bf16*)(WT), (ROFF), scr, it, lane, va); } } }
#define TR_W1IN(l)  TR_MAT(1, p.in(12) + (size_t)(l) * 1024 * 5632, 1024, 5632, ws + WS_W1IN + (l) * SZ_WIN, 0, p.in(11) + (l) * 1024, 1024)
#define TR_W2IN(l)  TR_MAT(1, p.in(34) + (size_t)(l) * 1024 * 5632, 1024, 5632, ws + WS_W2IN + (l) * SZ_WIN, 0, p.in(33) + (l) * 1024, 1024)
#define TR_W1OUT(l) TR_MAT(0, p.in(13) + (size_t)(l) * 2816 * 1024, 2816, 1024, ws + WS_W1OUT + (l) * SZ_WOUT, 0, (const float*)nullptr, 0)
#define TR_W2OUT(l) TR_MAT(0, p.in(35) + (size_t)(l) * 2816 * 1024, 2816, 1024, ws + WS_W2OUT + (l) * SZ_WOUT, 0, (const float*)nullptr, 0)
#define TR_WXQ(l)   TR_MAT(0, p.in(30) + (size_t)(l) * 1024 * 1024, 1024, 1024, ws + WS_WXQ + (l) * SZ_SQ, 0, p.in(28) + (l) * 1024, 1024)
#define TR_WXO(l)   TR_MAT(0, p.in(32) + (size_t)(l) * 1024 * 1024, 1024, 1024, ws + WS_WXO + (l) * SZ_SQ, 0, (const float*)nullptr, 0)
#define TR_WXKV(l)  TR_MAT(0, p.in(31) + (size_t)(l) * 1024 * 2048, 1024, 2048, ws + WS_WXKV, 2048 * (l), p.in(29) + (l) * 1024, 1024)
    if constexpr (SET == 0) {
        TR_W1IN(0)
        TR_MAT(2, p.in(15), 1024, 11296, ws + WS_WINAB, 0, p.in(14), 1024)
        TR_WXKV(0) TR_WXKV(1)
        TR_MAT(0, p.in(22), 4096, 1024, ws + WS_WOUTAB, 0, p.in(21), 2048)
    }
    if constexpr (SET == 1) { TR_W1OUT(0) TR_W2IN(0) TR_WXQ(0) TR_WXO(0) }
    if constexpr (SET == 2) {
        TR_W2OUT(0) TR_W1IN(1)
        TR_MAT(0, p.in(27), 1024, 1024, ws + WS_WOUTC, 0, p.in(26), 1024)
        TR_WXQ(1) TR_WXO(1)
    }
    if constexpr (SET == 3) {
        TR_W1OUT(1) TR_W2IN(1)
        TR_MAT(3, p.in(23), 1024, 3080, ws + WS_WINC, 0, p.in(14) + 1024, 1024)
    }
    if constexpr (SET == 4) { TR_W2OUT(1) }
#undef TR_MAT
#undef TR_W1IN
#undef TR_W2IN
#undef TR_W1OUT
#undef TR_W2OUT
#undef TR_WXQ
#undef TR_WXO
#undef TR_WXKV
}
template <unsigned PM>
__device__ __forceinline__ void prologue(const Ctx& p, ldsp lds, int vcu, int G) {
    const int tid = opaque_tid(), lane = tid & 63, wave = tid >> 6;
    unsigned char* ws = p.ws;
    const int gw = vcu * 8 + wave, NGW = G * 8;
    if constexpr ((PM & 1u) != 0) convert_set<0>(p, lds, vcu, G);
    if constexpr ((PM & 2u) != 0) {
    bf16* XB = (bf16*)(ws + WS_XB); float* slot = (float*)(ws + WS_SLOT);
    for (int row = gw; row < MP; row += 2 * NGW) {
        f32x4 v[2][4]; float ss[2] = {0.f, 0.f};
#pragma unroll
        for (int q = 0; q < 2; ++q) {
            const int r = row + q * NGW;
            const int rc = r < MR ? r : 0;
            const f32x4* src = (const f32x4*)(rc < NP ? p.in(0) + (size_t)rc * D : p.in(1) + (size_t)(rc - NP) * D) + lane;
#pragma unroll
            for (int j = 0; j < 4; ++j) v[q][j] = src[64 * j];
        }
#pragma unroll
        for (int q = 0; q < 2; ++q) {
            const int r = row + q * NGW;
            if (r < MP) {
#pragma unroll
                for (int j = 0; j < 4; ++j) { if (r >= MR) v[q][j] = (f32x4){0.f, 0.f, 0.f, 0.f}; ss[q] += (v[q][j].x * v[q][j].x + v[q][j].y * v[q][j].y) + (v[q][j].z * v[q][j].z + v[q][j].w * v[q][j].w); }
                const float tot = wave_sum(ss[q]);
                u32x2* bo = (u32x2*)(XB + (size_t)r * D) + lane;
#pragma unroll
                for (int j = 0; j < 4; ++j) { u32x2 w; w.x = pk2(v[q][j].x, v[q][j].y); w.y = pk2(v[q][j].z, v[q][j].w); bo[64 * j] = w; }
                if (lane < 16) slot[(size_t)r * 16 + lane] = lane == 0 ? tot : 0.f;
            }
        }
    }
    }
}
__device__ __forceinline__ void prologue_mem(const Ctx& p, int vcu, int G) {
    const int tid = opaque_tid(), lane = tid & 63, wave = tid >> 6;
    unsigned char* ws = p.ws;
    const int gw = vcu * 8 + wave, NGW = G * 8;
    {
    bf16* MB = (bf16*)(ws + WS_MEMB); float* mss = (float*)(ws + WS_MEMSS);
    for (int row = gw; row < 2048; row += NGW) {
        const f32x4* src = (const f32x4*)(p.in(10) + (size_t)row * D) + lane; float ss = 0.f; u32x2* bo = (u32x2*)(MB + (size_t)row * D) + lane;
#pragma unroll
        for (int j = 0; j < 4; ++j) { const f32x4 v = src[64 * j]; ss += (v.x * v.x + v.y * v.y) + (v.z * v.z + v.w * v.w); u32x2 w; w.x = pk2(v.x, v.y); w.y = pk2(v.z, v.w); bo[64 * j] = w; }
        ss = wave_sum(ss);
        if (lane == 0) mss[row] = ss;
    }
    f32x2* rot = (f32x2*)(ws + WS_ROT);
    for (int idx = vcu * 512 + tid; idx < 2049 * 128; idx += G * 512) {
        const int i = idx & 127, pr = idx >> 7; const int pos = pr == 2048 ? 16384 : pr;
        double inv = 1.0, bs = 0.9305720409296989; int e = i;
        while (e) { if (e & 1) inv *= bs; bs *= bs; e >>= 1; }
        const double rev = (double)pos * inv * 0.15915494309189535;
        const float fr = (float)(rev - floor(rev));
        rot[idx] = (f32x2){__builtin_amdgcn_cosf(fr), __builtin_amdgcn_sinf(fr)};
    }
    }
}
__device__ __forceinline__ void conv_unit(const Ctx& p, int u) {
    const int tid = opaque_tid();
    unsigned char* ws = p.ws;
    const bf16* P = (const bf16*)(ws + WS_P); bf16* XC = (bf16*)(ws + WS_XC);
    const float* cw = p.in(16); const float* cb = p.in(17);
    const int b = u >> 5, blk = u & 31;
    if (tid < 384) {
        const int c0 = 8 * tid;
        f32x4 w[4][2], bb[2];
#pragma unroll
        for (int j = 0; j < 4; ++j) { w[j][0] = *(const f32x4*)(cw + j * 3072 + c0); w[j][1] = *(const f32x4*)(cw + j * 3072 + c0 + 4); }
        bb[0] = *(const f32x4*)(cb + c0); bb[1] = *(const f32x4*)(cb + c0 + 4);
        const size_t row0 = (size_t)b * SEQ + 64 * blk;
        const bf16* src = P + row0 * NAB + PX + c0; bf16* dst = XC + row0 * 3072 + c0;
        u32x4 win[3];
#pragma unroll
        for (int j = 0; j < 3; ++j) win[j] = blk > 0 ? *(const u32x4*)(src - (size_t)(3 - j) * NAB) : (u32x4){0u, 0u, 0u, 0u};
#pragma unroll 1
        for (int r0 = 0; r0 < 64; r0 += 8) {
            u32x4 cur[8];
#pragma unroll
            for (int r = 0; r < 8; ++r) cur[r] = *(const u32x4*)(src + (size_t)(r0 + r) * NAB);
#pragma unroll
            for (int r = 0; r < 8; ++r) {
                float u0[8], u1[8], u2[8], u3[8], o[8];
                unpack8(win[0], u0); unpack8(win[1], u1); unpack8(win[2], u2); unpack8(cur[r], u3);
#pragma unroll
                for (int e = 0; e < 8; ++e) { const int hh = e >> 2, ee = e & 3;
                    o[e] = siluf(bb[hh][ee] + w[0][hh][ee] * u0[e] + w[1][hh][ee] * u1[e] + w[2][hh][ee] * u2[e] + w[3][hh][ee] * u3[e]); }
                *(u32x4*)(dst + (size_t)(r0 + r) * 3072) = pack8(o);
                win[0] = win[1]; win[1] = win[2]; win[2] = cur[r];
            }
        }
        if (blk == 31) {
            float* co = p.out + O_CONVP + (size_t)b * 3 * 3072 + c0;
#pragma unroll
            for (int j = 0; j < 3; ++j) { float v[8]; unpack8(win[j], v); *(f32x4*)(co + j * 3072) = (f32x4){v[0], v[1], v[2], v[3]}; *(f32x4*)(co + j * 3072 + 4) = (f32x4){v[4], v[5], v[6], v[7]}; }
        }
    }
    if (tid >= 320) {
        const int id = u * 192 + (tid - 320), i = id / 384, c0 = 8 * (id - i * 384);
        const size_t row = NP + i;
        const float* buf = p.in(4) + (size_t)i * 3 * 3072 + c0; float* co = p.out + O_CONVS + (size_t)i * 3 * 3072 + c0;
        float uu[8], o[8]; unpack8(*(const u32x4*)(P + row * NAB + PX + c0), uu);
#pragma unroll
        for (int hh = 0; hh < 2; ++hh) {
            const f32x4 b0 = *(const f32x4*)(buf + 4 * hh), b1 = *(const f32x4*)(buf + 3072 + 4 * hh), b2 = *(const f32x4*)(buf + 2 * 3072 + 4 * hh);
            const f32x4 w0 = *(const f32x4*)(cw + c0 + 4 * hh), w1 = *(const f32x4*)(cw + 3072 + c0 + 4 * hh), w2 = *(const f32x4*)(cw + 2 * 3072 + c0 + 4 * hh), w3 = *(const f32x4*)(cw + 3 * 3072 + c0 + 4 * hh);
            const f32x4 bs = *(const f32x4*)(cb + c0 + 4 * hh), uv = (f32x4){uu[4 * hh], uu[4 * hh + 1], uu[4 * hh + 2], uu[4 * hh + 3]};
            const f32x4 acc = bs + w0 * b0 + w1 * b1 + w2 * b2 + w3 * uv;
#pragma unroll
            for (int e = 0; e < 4; ++e) o[4 * hh + e] = siluf(acc[e]);
            *(f32x4*)(co + 4 * hh) = b1; *(f32x4*)(co + 3072 + 4 * hh) = b2; *(f32x4*)(co + 2 * 3072 + 4 * hh) = uv;
        }
        *(u32x4*)(XC + row * 3072 + c0) = pack8(o);
    }
}
__device__ __forceinline__ float ssd_dt_scan(const float* DT, size_t row0, int h, float bias, float a, LAS float* cs, LAS float* dtv, int lane) {
    const int s0 = 2 * lane;
    const float dt0 = softplusf(DT[(row0 + s0) * 32 + h] + bias), dt1 = softplusf(DT[(row0 + s0 + 1) * 32 + h] + bias);
    const float da0 = dt0 * a, da1 = dt1 * a;
    float v = da0 + da1;
#pragma unroll
    for (int o = 1; o < 64; o <<= 1) { const float t = __shfl_up(v, o); if (lane >= o) v += t; }
    cs[s0] = v - da1; cs[s0 + 1] = v; dtv[s0] = dt0; dtv[s0 + 1] = dt1;
    return __shfl(v, 63);
}

__device__ __forceinline__ void ssdA_unit(const Ctx& p, ldsp lds, int b, int h) {
    const int tid = opaque_tid(), lane = tid & 63, wave = __builtin_amdgcn_readfirstlane(tid >> 6), g = h >> 3;
    unsigned char* ws = p.ws;
    const bf16* XC = (const bf16*)(ws + WS_XC); const float* DT = (const float*)(ws + WS_DT); bf16* HC = (bf16*)(ws + WS_HC);
    ldsp XW = lds; ldsp BI = lds + 18432;
    LAS float* CS = (LAS float*)(lds + 53248); LAS float* DTV = (LAS float*)(lds + 61440); LAS float* TOTS = (LAS float*)(lds + 69632);
    {
        const float bias = p.in(18)[h], a = -expf(p.in(19)[h]);
#pragma unroll 1
        for (int cc = wave; cc < 16; cc += 8) { const float tot = ssd_dt_scan(DT, (size_t)b * SEQ + cc * 128, h, bias, a, CS + cc * 128, DTV + cc * 128, lane); if (lane == 0) TOTS[cc] = tot; }
    }
    const int pi = wave & 3, nj0 = (wave >> 2) * 4;
    const bf16* Px = XC + (size_t)b * SEQ * 3072 + 64 * h + 8 * (tid & 7); const bf16* Pbb = XC + (size_t)b * SEQ * 3072 + 2048 + 128 * g + 8 * (tid & 15);
    u32x4 rx[2][2], rb[2][4];
#define SSDA_LOAD(par, c_) { _Pragma("unroll") for (int i = 0; i < 2; ++i) rx[par][i] = *(const u32x4*)(Px + (size_t)((c_) * 128 + ((tid + 512 * i) >> 3)) * 3072); \
        _Pragma("unroll") for (int i = 0; i < 4; ++i) rb[par][i] = *(const u32x4*)(Pbb + (size_t)((c_) * 128 + ((tid + 512 * i) >> 4)) * 3072); }
    SSDA_LOAD(0, 0) SSDA_LOAD(1, 1)
    f32x4 acc[4];
#pragma unroll
    for (int j = 0; j < 4; ++j) acc[j] = (f32x4){0.f, 0.f, 0.f, 0.f};
    __syncthreads();
#pragma unroll 2
    for (int c = 0; c < 16; ++c) {
        const int par = c & 1;
        const float tot = TOTS[c];
#pragma unroll
        for (int i = 0; i < 2; ++i) {
            const int s = (tid + 512 * i) >> 3; float o[8]; unpack8(par ? rx[1][i] : rx[0][i], o);
            const float w = __expf(tot - CS[c * 128 + s]) * DTV[c * 128 + s];
#pragma unroll
            for (int e = 0; e < 8; ++e) o[e] *= w;
            *(LAS u32x4*)(XW + s * 144 + (tid & 7) * 16) = pack8(o);
        }
#pragma unroll
        for (int i = 0; i < 4; ++i) *(LAS u32x4*)(BI + ((tid + 512 * i) >> 4) * 272 + (tid & 15) * 16) = par ? rb[1][i] : rb[0][i];
        __syncthreads();
        if (c < 14) { if (par) SSDA_LOAD(1, c + 2) else SSDA_LOAD(0, c + 2) }
        {
            bf16* hc = HC + (((size_t)(b * 32 + h) * 16 + c) * 64) * 128;
#pragma unroll
            for (int j = 0; j < 4; ++j) { u32x2 w; w.x = pk2(acc[j][0], acc[j][1]); w.y = pk2(acc[j][2], acc[j][3]);
                *(u32x2*)(hc + (16 * pi + (lane & 15)) * 128 + 16 * (nj0 + j) + 4 * (lane >> 4)) = w; }
        }
        const float dec = __expf(tot);
#pragma unroll
        for (int j = 0; j < 4; ++j) acc[j] *= dec;
#pragma unroll
        for (int ks = 0; ks < 4; ++ks) {
            const bf16x8 Xf = trfrag(XW, 144, 32 * ks, 16 * pi, lane);
#pragma unroll
            for (int j = 0; j < 4; ++j) acc[j] = mfma16(trfrag(BI, 272, 32 * ks, 16 * (nj0 + j), lane), Xf, acc[j]);
        }
        __syncthreads();
    }
#undef SSDA_LOAD
    float* so = p.out + O_SSMP + ((size_t)(b * 32 + h) * 64) * 128;
#pragma unroll
    for (int j = 0; j < 4; ++j) *(f32x4*)(so + (16 * pi + (lane & 15)) * 128 + 16 * (nj0 + j) + 4 * (lane >> 4)) = acc[j];
}

__device__ __forceinline__ void retA_unit(const Ctx& p, ldsp lds, int b, int h, int dvs) {
    const int tid = opaque_tid(), lane = tid & 63, wave = __builtin_amdgcn_readfirstlane(tid >> 6);
    unsigned char* ws = p.ws;
    const bf16* P = (const bf16*)(ws + WS_P); bf16* SC = (bf16*)(ws + WS_SC);
    ldsp KW = lds; ldsp VI = lds + 67584;
    const float lg2 = log2f(1.f - exp2f(-5.f - (float)h));
    const float g128 = exp2f(128.f * lg2);
    f32x4 acc[2][4];
#pragma unroll
    for (int i = 0; i < 2; ++i)
#pragma unroll
        for (int j = 0; j < 4; ++j) acc[i][j] = (f32x4){0.f, 0.f, 0.f, 0.f};
    const bf16* Pk = P + (size_t)b * SEQ * NAB + PRK + 256 * h + 8 * (tid & 31); const bf16* Pv = P + (size_t)b * SEQ * NAB + PRV + 512 * h + 64 * dvs + 8 * (tid & 7);
    u32x4 rk[2][8], rv[2][2];
#define RETA_LOAD(par, c_) { _Pragma("unroll") for (int i = 0; i < 8; ++i) rk[par][i] = *(const u32x4*)(Pk + (size_t)((c_) * 128 + ((tid + 512 * i) >> 5)) * NAB); \
        _Pragma("unroll") for (int i = 0; i < 2; ++i) rv[par][i] = *(const u32x4*)(Pv + (size_t)((c_) * 128 + ((tid + 512 * i) >> 3)) * NAB); }
    RETA_LOAD(0, 0) RETA_LOAD(1, 1)
#pragma unroll 2
    for (int c = 0; c < 16; ++c) {
        const int par = c & 1;
#pragma unroll
        for (int i = 0; i < 8; ++i) {
            const int s = (tid + 512 * i) >> 5; float k[8]; unpack8(par ? rk[1][i] : rk[0][i], k);
            const float w = exp2f((float)(127 - s) * lg2);
#pragma unroll
            for (int e = 0; e < 8; ++e) k[e] *= w;
            *(LAS u32x4*)(KW + s * 528 + (tid & 31) * 16) = pack8(k);
        }
#pragma unroll
        for (int i = 0; i < 2; ++i) *(LAS u32x4*)(VI + ((tid + 512 * i) >> 3) * 144 + (tid & 7) * 16) = par ? rv[1][i] : rv[0][i];
        __syncthreads();
        if (c < 14) { if (par) RETA_LOAD(1, c + 2) else RETA_LOAD(0, c + 2) }
        {
            bf16* sc = SC + (((size_t)(b * 4 + h) * 16 + c) * 512) * 256;
#pragma unroll
            for (int i = 0; i < 2; ++i)
#pragma unroll
                for (int j = 0; j < 4; ++j) { u32x2 w; w.x = pk2(acc[i][j][0], acc[i][j][1]); w.y = pk2(acc[i][j][2], acc[i][j][3]);
                    *(u32x2*)(sc + (size_t)(64 * dvs + 16 * j + (lane & 15)) * 256 + 16 * (2 * wave + i) + 4 * (lane >> 4)) = w; }
        }
#pragma unroll
        for (int i = 0; i < 2; ++i)
#pragma unroll
            for (int j = 0; j < 4; ++j) acc[i][j] *= g128;
#pragma unroll
        for (int ks = 0; ks < 4; ++ks) {
            const bf16x8 A0 = trfrag(KW, 528, 32 * ks, 16 * (2 * wave), lane), A1 = trfrag(KW, 528, 32 * ks, 16 * (2 * wave + 1), lane);
#pragma unroll
            for (int j = 0; j < 4; ++j) { const bf16x8 B = trfrag(VI, 144, 32 * ks, 16 * j, lane); acc[0][j] = mfma16(A0, B, acc[0][j]); acc[1][j] = mfma16(A1, B, acc[1][j]); }
        }
        __syncthreads();
    }
#undef RETA_LOAD
    float* so = p.out + O_RETP + ((size_t)(b * 4 + h) * 256) * 512;
#pragma unroll
    for (int i = 0; i < 2; ++i)
#pragma unroll
        for (int j = 0; j < 4; ++j)
#pragma unroll
            for (int r = 0; r < 4; ++r) so[(size_t)(16 * (2 * wave + i) + 4 * (lane >> 4) + r) * 512 + 64 * dvs + 16 * j + (lane & 15)] = acc[i][j][r];
}

__device__ __forceinline__ float block_sum8(float v, LAS float* red, int lane, int wave) {
    v = wave_sum(v);
    __syncthreads();
    if (lane == 0) red[wave] = v;
    __syncthreads();
    return ((red[0] + red[1]) + (red[2] + red[3])) + ((red[4] + red[5]) + (red[6] + red[7]));
}

__device__ __forceinline__ void ssdS_unit(const Ctx& p, ldsp lds, int b, int g) {
    const int tid = opaque_tid(), lane = tid & 63, wave = __builtin_amdgcn_readfirstlane(tid >> 6);
    unsigned char* ws = p.ws;
    const bf16* P = (const bf16*)(ws + WS_P); const float* DT = (const float*)(ws + WS_DT); bf16* Y = (bf16*)(ws + WS_R3);
    const size_t row = NP + b;
    LAS float* XS = (LAS float*)lds; LAS float* BS = XS + 512; LAS float* CS = BS + 128; LAS float* YS = CS + 128; LAS float* DTS = YS + 512; LAS float* DAS = DTS + 8; LAS float* RED = DAS + 8;
    const bf16* XC = (const bf16*)(ws + WS_XC);
    for (int ci = tid; ci < 768; ci += 512) {
        const int xc = ci < 512 ? 512 * g + ci : (ci < 640 ? 2048 + 128 * g + (ci - 512) : 2560 + 128 * g + (ci - 640));
        XS[ci] = bf2f(XC[row * 3072 + xc]);
    }
    if (tid < 8) { const int h = 8 * g + tid; const float dt = softplusf(DT[row * 32 + h] + p.in(18)[h]); DTS[tid] = dt; DAS[tid] = expf(dt * (-expf(p.in(19)[h]))); }
    __syncthreads();
    const int pp = tid >> 3, ng = tid & 7;
#pragma unroll 1
    for (int h2 = 0; h2 < 8; h2 += 2) {
        f32x4 sv[2][4];
#pragma unroll
        for (int e = 0; e < 2; ++e) { const f32x4* si = (const f32x4*)(p.in(5) + (((size_t)b * 32 + 8 * g + h2 + e) * 64 + pp) * 128 + ng * 16);
#pragma unroll
            for (int q = 0; q < 4; ++q) sv[e][q] = ldnt4((const float*)(si + q)); }
#pragma unroll
        for (int e = 0; e < 2; ++e) {
            const int hh = h2 + e, h = 8 * g + hh;
            f32x4* so = (f32x4*)(p.out + O_SSMS + (((size_t)b * 32 + h) * 64 + pp) * 128 + ng * 16);
            const float x = XS[64 * hh + pp], dt = DTS[hh], dA = DAS[hh], xd = x * dt;
            float y = 0.f;
#pragma unroll
            for (int q = 0; q < 4; ++q) {
                const f32x4 Bv = *(const LAS f32x4*)(BS + ng * 16 + 4 * q), Cv = *(const LAS f32x4*)(CS + ng * 16 + 4 * q);
                const f32x4 nsv = sv[e][q] * dA + xd * Bv; stnt4((float*)(so + q), nsv);
                y += (nsv.x * Cv.x + nsv.y * Cv.y) + (nsv.z * Cv.z + nsv.w * Cv.w);
            }
            y += __shfl_xor(y, 1); y += __shfl_xor(y, 2); y += __shfl_xor(y, 4);
            if (ng == 0) { const float z = bf2f(P[row * NAB + PZ + 64 * h + pp]); YS[64 * hh + pp] = (y + x * p.in(20)[h]) * siluf(z); }
        }
    }
    __syncthreads();
    const float yv = YS[tid];
    const float tot = block_sum8(yv * yv, RED, lane, wave);
    Y[row * 4096 + 512 * g + tid] = (bf16)(pk2(yv * rsqrtf(tot * (1.f / 512.f) + 1e-6f), 0.f) & 0xffffu);
    __syncthreads();
}

__device__ __forceinline__ void retS_unit(const Ctx& p, ldsp lds, int b, int h) {
    const int tid = opaque_tid(), lane = tid & 63, wave = __builtin_amdgcn_readfirstlane(tid >> 6);
    unsigned char* ws = p.ws;
    const bf16* P = (const bf16*)(ws + WS_P); bf16* Y = (bf16*)(ws + WS_R3);
    const size_t row = NP + b;
    LAS float* QS = (LAS float*)lds; LAS float* KS = QS + 256; LAS float* VS = KS + 256; LAS float* RD = VS + 512; LAS float* RED = RD + 2048;
    const int dvq = tid & 127, dkg = tid >> 7;
    const size_t sb = ((size_t)(b * 4 + h) * 256) * 512 + 4 * dvq;
    const float* si = p.in(6) + sb; float* so = p.out + O_RETS + sb;
    f32x4 s[16];
#pragma unroll
    for (int j = 0; j < 16; ++j) s[j] = ldnt4(si + (size_t)(dkg + 4 * j) * 512);
    if (tid < 256) { QS[tid] = bf2f(P[row * NAB + PRQ + 256 * h + tid]); KS[tid] = bf2f(P[row * NAB + PRK + 256 * h + tid]); }
    VS[tid] = bf2f(P[row * NAB + PRV + 512 * h + tid]);
    __syncthreads();
    const float gam = 1.f - exp2f(-5.f - (float)h);
    const f32x4 v4 = *(const LAS f32x4*)(VS + 4 * dvq);
    f32x4 o4 = (f32x4){0.f, 0.f, 0.f, 0.f};
#pragma unroll 1
    for (int i0 = 0; i0 < 64; i0 += 16) {
        if (i0 > 0) {
#pragma unroll
            for (int j = 0; j < 16; ++j) s[j] = ldnt4(si + (size_t)(dkg + 4 * (i0 + j)) * 512);
        }
#pragma unroll
        for (int j = 0; j < 16; ++j) {
            const int dk = dkg + 4 * (i0 + j);
            const f32x4 nsv = gam * s[j] + KS[dk] * v4;
            stnt4(so + (size_t)dk * 512, nsv);
            o4 += QS[dk] * nsv;
        }
    }
    *(LAS f32x4*)(RD + dkg * 512 + 4 * dvq) = o4;
    __syncthreads();
    const float o = (RD[tid] + RD[512 + tid]) + (RD[1024 + tid] + RD[1536 + tid]);
    const float tot = block_sum8(o * o, RED, lane, wave);
    const float rg = bf2f(P[row * NAB + PRG + 512 * h + tid]);
    Y[row * 4096 + 2048 + 512 * h + tid] = (bf16)(pk2(siluf(rg) * o * rsqrtf(tot * (1.f / 512.f) + 1e-6f), 0.f) & 0xffffu);
    __syncthreads();
}

__device__ __forceinline__ void ssdB_unit(const Ctx& p, ldsp lds, int b, int g, int c) {
    const int tid = opaque_tid(), lane = tid & 63, wave = __builtin_amdgcn_readfirstlane(tid >> 6);
    unsigned char* ws = p.ws;
    const bf16* P = (const bf16*)(ws + WS_P); const bf16* XC = (const bf16*)(ws + WS_XC); const float* DT = (const float*)(ws + WS_DT); const bf16* HC = (const bf16*)(ws + WS_HC); bf16* Y = (bf16*)(ws + WS_R3);
    ldsp CI = lds; ldsp BI = lds + 34816; ldsp XD = lds + 34816; ldsp HI = lds + 53248;
    LAS float* CSH = (LAS float*)(lds + 70656); LAS float* DTH = (LAS float*)(lds + 74752);
    const size_t row0 = (size_t)b * SEQ + c * 128;
    {
        u32x4 rb[4], rc[4];
#pragma unroll
        for (int i = 0; i < 4; ++i) { const bf16* src = XC + (row0 + ((tid + 512 * i) >> 4)) * 3072 + 2048 + 128 * g + 8 * (tid & 15); rb[i] = *(const u32x4*)src; rc[i] = *(const u32x4*)(src + 512); }
        { const int h = 8 * g + wave; (void)ssd_dt_scan(DT, row0, h, p.in(18)[h], -expf(p.in(19)[h]), CSH + wave * 128, DTH + wave * 128, lane); }
#pragma unroll
        for (int i = 0; i < 4; ++i) { const int s = (tid + 512 * i) >> 4, cg = tid & 15; *(LAS u32x4*)(BI + s * 272 + cg * 16) = rb[i]; *(LAS u32x4*)(CI + s * 272 + cg * 16) = rc[i]; }
    }
    u32x4 rx[2], rh[2]; u32x2 rz[4];
    const bf16* zsrc = P + (row0 + 16 * wave + (lane & 15)) * NAB + PZ + 512 * g + 4 * (lane >> 4);
    const bf16* xsrc = XC + (row0 + (tid >> 3)) * 3072 + 512 * g + 8 * (tid & 7);
    const bf16* hsrc = HC + (((size_t)(b * 32 + 8 * g) * 16 + c) * 64) * 128 + (tid >> 4) * 128 + (tid & 15) * 8;
#pragma unroll
    for (int i = 0; i < 2; ++i) { rx[i] = *(const u32x4*)(xsrc + (size_t)i * 64 * 3072); rh[i] = *(const u32x4*)(hsrc + i * 32 * 128); }
#pragma unroll
    for (int pj = 0; pj < 4; ++pj) rz[pj] = *(const u32x2*)(zsrc + 16 * pj);
    __syncthreads();
    f32x4 ST[8];
#pragma unroll
    for (int sj = 0; sj < 8; ++sj) ST[sj] = (f32x4){0.f, 0.f, 0.f, 0.f};
    bf16x8 CF[4];
#pragma unroll
    for (int ks = 0; ks < 4; ++ks) CF[ks] = rowfrag(CI, 272, 16 * wave, 32 * ks, lane);
#pragma unroll
    for (int sj = 0; sj < 8; ++sj) if (sj <= wave) {
#pragma unroll
        for (int ks = 0; ks < 4; ++ks) ST[sj] = mfma16(rowfrag(BI, 272, 16 * sj, 32 * ks, lane), CF[ks], ST[sj]);
    }
    __syncthreads();
    const int tl = 16 * wave + (lane & 15);
    float ss = 0.f;
#pragma unroll 1
    for (int hh = 0; hh < 8; ++hh) {
        const int h = 8 * g + hh;
#pragma unroll
        for (int i = 0; i < 2; ++i) {
            const int s = (tid + 512 * i) >> 3; float o[8]; unpack8(rx[i], o);
            const float w = DTH[hh * 128 + s];
#pragma unroll
            for (int e = 0; e < 8; ++e) o[e] *= w;
            *(LAS u32x4*)(XD + s * 144 + (tid & 7) * 16) = pack8(o);
            *(LAS u32x4*)(HI + ((tid + 512 * i) >> 4) * 272 + (tid & 15) * 16) = rh[i];
        }
        u32x2 zc[4];
#pragma unroll
        for (int pj = 0; pj < 4; ++pj) zc[pj] = rz[pj];
        __syncthreads();
        if (hh < 7) {
#pragma unroll
            for (int pj = 0; pj < 4; ++pj) rz[pj] = *(const u32x2*)(zsrc + 64 * (hh + 1) + 16 * pj);
#pragma unroll
            for (int i = 0; i < 2; ++i) { rx[i] = *(const u32x4*)(xsrc + 64 * (hh + 1) + (size_t)i * 64 * 3072); rh[i] = *(const u32x4*)(hsrc + (size_t)(hh + 1) * 16 * 64 * 128 + i * 32 * 128); }
        }
        const LAS float* csh = CSH + hh * 128;
        const float cst = csh[tl];
        f32x4 yT[4], yI[4];
#pragma unroll
        for (int pj = 0; pj < 4; ++pj) { yT[pj] = (f32x4){0.f, 0.f, 0.f, 0.f}; yI[pj] = (f32x4){0.f, 0.f, 0.f, 0.f}; }
#pragma unroll
        for (int ks = 0; ks < 4; ++ks) if (2 * ks <= wave) {
            f32x4 pa, pb;
#pragma unroll
            for (int r = 0; r < 4; ++r) {
                const int s0 = 32 * ks + 4 * (lane >> 4) + r, s1 = s0 + 16;
                pa[r] = s0 <= tl ? ST[2 * ks][r] * __expf(cst - csh[s0]) : 0.f;
                pb[r] = s1 <= tl ? ST[2 * ks + 1][r] * __expf(cst - csh[s1]) : 0.f;
            }
            const bf16x8 Pf = packP(pa, pb);
#pragma unroll
            for (int pj = 0; pj < 4; ++pj) yT[pj] = mfma16(trfragp(XD, 144, 32 * ks, 16 * pj, lane), Pf, yT[pj]);
        }
#pragma unroll
        for (int ks = 0; ks < 4; ++ks)
#pragma unroll
            for (int pj = 0; pj < 4; ++pj) yI[pj] = mfma16(rowfrag(HI, 272, 16 * pj, 32 * ks, lane), CF[ks], yI[pj]);
        const float ecs = __expf(cst), dsk = p.in(20)[h] / DTH[hh * 128 + tl];
#pragma unroll
        for (int pj = 0; pj < 4; ++pj) {
            const int pc = 16 * pj + 4 * (lane >> 4);
            const u32x2 xw = *(const LAS u32x2*)(XD + tl * 144 + pc * 2);
            const u32x2 zw = zc[pj];
            const float xv[4] = {bflo(xw.x), bfhi(xw.x), bflo(xw.y), bfhi(xw.y)}, zv[4] = {bflo(zw.x), bfhi(zw.x), bflo(zw.y), bfhi(zw.y)};
            float yv[4];
#pragma unroll
            for (int r = 0; r < 4; ++r) { yv[r] = (yT[pj][r] + ecs * yI[pj][r] + dsk * xv[r]) * siluf(zv[r]); ss += yv[r] * yv[r]; }
            u32x2 yw; yw.x = pk2(yv[0], yv[1]); yw.y = pk2(yv[2], yv[3]);
            *(u32x2*)(Y + (row0 + tl) * 4096 + 512 * g + 64 * hh + pc) = yw;
        }
        __syncthreads();
    }
    ss += __shfl_xor(ss, 16); ss += __shfl_xor(ss, 32);
    const float rstd = rsqrtf(ss * (1.f / 512.f) + 1e-6f);
    asm volatile("s_waitcnt vmcnt(0)" ::: "memory");
#pragma unroll 1
    for (int h2 = 0; h2 < 8; h2 += 4) {
        u32x2 v[4][4];
#pragma unroll
        for (int hh = 0; hh < 4; ++hh)
#pragma unroll
            for (int pj = 0; pj < 4; ++pj) v[hh][pj] = *(const u32x2*)(Y + (row0 + tl) * 4096 + 512 * g + 64 * (h2 + hh) + 16 * pj + 4 * (lane >> 4));
#pragma unroll
        for (int hh = 0; hh < 4; ++hh)
#pragma unroll
            for (int pj = 0; pj < 4; ++pj) {
                u32x2 w; w.x = pk2(bflo(v[hh][pj].x) * rstd, bfhi(v[hh][pj].x) * rstd); w.y = pk2(bflo(v[hh][pj].y) * rstd, bfhi(v[hh][pj].y) * rstd);
                *(u32x2*)(Y + (row0 + tl) * 4096 + 512 * g + 64 * (h2 + hh) + 16 * pj + 4 * (lane >> 4)) = w;
            }
    }
}

__device__ __forceinline__ void retF_unit(const Ctx& p, ldsp lds, int b, int h, int dvs) {
    const int tid = opaque_tid(), lane = tid & 63, wave = __builtin_amdgcn_readfirstlane(tid >> 6);
    unsigned char* ws = p.ws;
    const bf16* P = (const bf16*)(ws + WS_P); bf16* Y = (bf16*)(ws + WS_R3); float* RSS = (float*)(ws + WS_RSS);
    ldsp KI = lds; ldsp VI = lds + 67584; ldsp VW = lds + 86016; ldsp SI = lds + 104448;
    const float lg2 = log2f(1.f - exp2f(-5.f - (float)h));
    const float g128 = exp2f(128.f * lg2);
    const int tl = 16 * wave + (lane & 15);
    f32x4 acc[2][4];
#pragma unroll
    for (int i = 0; i < 2; ++i)
#pragma unroll
        for (int j = 0; j < 4; ++j) acc[i][j] = (f32x4){0.f, 0.f, 0.f, 0.f};
    const bf16* Pk = P + (size_t)b * SEQ * NAB + PRK + 256 * h + 8 * (tid & 31); const bf16* Pv = P + (size_t)b * SEQ * NAB + PRV + 512 * h + 64 * dvs + 8 * (tid & 7);
    const bf16* Pq = P + ((size_t)b * SEQ + tl) * NAB + PRQ + 256 * h + 8 * (lane >> 4);
    u32x4 rk[8], rv[2], rq[8];
#define RETF_LOAD(c_) { _Pragma("unroll") for (int i = 0; i < 8; ++i) rk[i] = *(const u32x4*)(Pk + (size_t)((c_) * 128 + ((tid + 512 * i) >> 5)) * NAB); \
        _Pragma("unroll") for (int i = 0; i < 2; ++i) rv[i] = *(const u32x4*)(Pv + (size_t)((c_) * 128 + ((tid + 512 * i) >> 3)) * NAB); }
#define RETF_LOADQ(c_) { _Pragma("unroll") for (int ks = 0; ks < 8; ++ks) rq[ks] = *(const u32x4*)(Pq + (size_t)(c_) * 128 * NAB + 32 * ks); }
    RETF_LOAD(0) RETF_LOADQ(0)
    const float qs = exp2f((float)(tl + 1) * lg2);
#pragma unroll 1
    for (int c = 0; c < 16; ++c) {
        const size_t row0 = (size_t)b * SEQ + c * 128;
#pragma unroll
        for (int i = 0; i < 8; ++i) *(LAS u32x4*)(KI + ((tid + 512 * i) >> 5) * 528 + (tid & 31) * 16) = rk[i];
#pragma unroll
        for (int i = 0; i < 2; ++i) {
            const int s = (tid + 512 * i) >> 3;
            *(LAS u32x4*)(VI + s * 144 + (tid & 7) * 16) = rv[i];
            float v[8]; unpack8(rv[i], v); const float w = exp2f((float)(127 - s) * lg2);
#pragma unroll
            for (int e = 0; e < 8; ++e) v[e] *= w;
            *(LAS u32x4*)(VW + s * 144 + (tid & 7) * 16) = pack8(v);
        }
#pragma unroll
        for (int i = 0; i < 2; ++i)
#pragma unroll
            for (int j = 0; j < 4; ++j) { u32x2 w; w.x = pk2(acc[i][j][0], acc[i][j][1]); w.y = pk2(acc[i][j][2], acc[i][j][3]);
                *(LAS u32x2*)(SI + (16 * j + (lane & 15)) * 528 + (16 * (2 * wave + i) + 4 * (lane >> 4)) * 2) = w; }
        bf16x8 QF[8];
#pragma unroll
        for (int ks = 0; ks < 8; ++ks) { float q[8]; unpack8(rq[ks], q);
#pragma unroll
            for (int e = 0; e < 8; ++e) q[e] *= qs;
            QF[ks] = __builtin_bit_cast(bf16x8, pack8(q)); }
        u32x2 gwv[4];
#pragma unroll
        for (int j = 0; j < 4; ++j) gwv[j] = *(const u32x2*)(P + (row0 + tl) * NAB + PRG + 512 * h + 64 * dvs + 16 * j + 4 * (lane >> 4));
        __syncthreads();
        if (c < 15) RETF_LOAD(c + 1)
        __builtin_amdgcn_sched_barrier(0);
        f32x4 oT[4];
#pragma unroll
        for (int j = 0; j < 4; ++j) oT[j] = (f32x4){0.f, 0.f, 0.f, 0.f};
        int lq = lane >> 4; asm volatile("" : "+v"(lq));
#pragma unroll
        for (int ks = 0; ks < 4; ++ks) if (2 * ks <= wave) {
            f32x4 sa = (f32x4){0.f, 0.f, 0.f, 0.f}, sb = (f32x4){0.f, 0.f, 0.f, 0.f};
#pragma unroll
            for (int kk = 0; kk < 8; ++kk) {
                sa = mfma16(rowfrag(KI, 528, 32 * ks, 32 * kk, lane), QF[kk], sa);
                sb = mfma16(rowfrag(KI, 528, 32 * ks + 16, 32 * kk, lane), QF[kk], sb);
            }
            f32x4 pa, pb;
#pragma unroll
            for (int r = 0; r < 4; ++r) {
                const int s0 = 32 * ks + 4 * lq + r, s1 = s0 + 16;
                pa[r] = s0 <= tl ? sa[r] * exp2f(-(float)(s0 + 1) * lg2) : 0.f;
                pb[r] = s1 <= tl ? sb[r] * exp2f(-(float)(s1 + 1) * lg2) : 0.f;
            }
            const bf16x8 Pf = packP(pa, pb);
#pragma unroll
            for (int j = 0; j < 4; ++j) oT[j] = mfma16(trfragp(VI, 144, 32 * ks, 16 * j, lane), Pf, oT[j]);
            __builtin_amdgcn_sched_barrier(0);
        }
#pragma unroll
        for (int j = 0; j < 4; ++j)
#pragma unroll
            for (int ks = 0; ks < 8; ++ks) oT[j] = mfma16(rowfrag(SI, 528, 16 * j, 32 * ks, lane), QF[ks], oT[j]);
        __builtin_amdgcn_sched_barrier(0);
        {
            float ss = 0.f;
#pragma unroll
            for (int j = 0; j < 4; ++j) {
                const int dv = 64 * dvs + 16 * j + 4 * (lane >> 4);
                const u32x2 gw = gwv[j];
                ss += (oT[j][0] * oT[j][0] + oT[j][1] * oT[j][1]) + (oT[j][2] * oT[j][2] + oT[j][3] * oT[j][3]);
                u32x2 w; w.x = pk2(siluf(bflo(gw.x)) * oT[j][0], siluf(bfhi(gw.x)) * oT[j][1]); w.y = pk2(siluf(bflo(gw.y)) * oT[j][2], siluf(bfhi(gw.y)) * oT[j][3]);
                *(u32x2*)(Y + (row0 + tl) * 4096 + 2048 + 512 * h + dv) = w;
            }
            ss += __shfl_xor(ss, 16); ss += __shfl_xor(ss, 32);
            if (lane < 16) RSS[(row0 + tl) * 32 + 8 * h + dvs] = ss;
        }
        __builtin_amdgcn_sched_barrier(0);
        if (c < 15) RETF_LOADQ(c + 1)
#pragma unroll
        for (int i = 0; i < 2; ++i)
#pragma unroll
            for (int j = 0; j < 4; ++j) acc[i][j] *= g128;
#pragma unroll
        for (int ks = 0; ks < 4; ++ks) {
            const bf16x8 A0 = trfrag(KI, 528, 32 * ks, 16 * (2 * wave), lane), A1 = trfrag(KI, 528, 32 * ks, 16 * (2 * wave + 1), lane);
#pragma unroll
            for (int j = 0; j < 4; ++j) { const bf16x8 B = trfrag(VW, 144, 32 * ks, 16 * j, lane); acc[0][j] = mfma16(A0, B, acc[0][j]); acc[1][j] = mfma16(A1, B, acc[1][j]); }
        }
        __syncthreads();
    }
#undef RETF_LOAD
#undef RETF_LOADQ
    float* so = p.out + O_RETP + ((size_t)(b * 4 + h) * 256) * 512;
#pragma unroll
    for (int i = 0; i < 2; ++i)
#pragma unroll
        for (int j = 0; j < 4; ++j)
#pragma unroll
            for (int r = 0; r < 4; ++r) so[(size_t)(16 * (2 * wave + i) + 4 * (lane >> 4) + r) * 512 + 64 * dvs + 16 * j + (lane & 15)] = acc[i][j][r];
}
__device__ __forceinline__ void retN_unit(const Ctx& p, int u) {
    const int tid = opaque_tid();
    bf16* Y = (bf16*)(p.ws + WS_R3); const float* RSS = (const float*)(p.ws + WS_RSS);
    const int cg = tid & 255, h = cg >> 6;
#pragma unroll 1
    for (int r0 = tid >> 8; r0 < 64; r0 += 16) {
        u32x4 raw[8]; float rstd[8];
#pragma unroll
        for (int q = 0; q < 8; ++q) {
            const size_t row = (size_t)u * 64 + r0 + 2 * q;
            raw[q] = *(const u32x4*)(Y + row * 4096 + 2048 + 8 * cg);
            const f32x4 s0 = *(const f32x4*)(RSS + row * 32 + 8 * h), s1 = *(const f32x4*)(RSS + row * 32 + 8 * h + 4);
            rstd[q] = rsqrtf(((s0.x + s0.y) + (s0.z + s0.w) + (s1.x + s1.y) + (s1.z + s1.w)) * (1.f / 512.f) + 1e-6f);
        }
#pragma unroll
        for (int q = 0; q < 8; ++q) {
            const size_t row = (size_t)u * 64 + r0 + 2 * q;
            float v[8]; unpack8(raw[q], v);
#pragma unroll
            for (int e = 0; e < 8; ++e) v[e] *= rstd[q];
            *(u32x4*)(Y + row * 4096 + 2048 + 8 * cg) = pack8(v);
        }
    }
}
__device__ __forceinline__ void ssdF_unit(const Ctx& p, ldsp lds, int b, int h) {
    const int tid = opaque_tid(), lane = tid & 63, wave = __builtin_amdgcn_readfirstlane(tid >> 6), g = h >> 3;
    unsigned char* ws = p.ws;
    const bf16* P = (const bf16*)(ws + WS_P); const bf16* XC = (const bf16*)(ws + WS_XC); const float* DT = (const float*)(ws + WS_DT); bf16* Y = (bf16*)(ws + WS_R3); float* SSS = (float*)(ws + WS_SSS);
    ldsp BI = lds; ldsp XD = lds + 34816; ldsp XW = lds + 53248; ldsp HI = lds + 71680;
    LAS float* CS = (LAS float*)(lds + 89088); LAS float* DTV = (LAS float*)(lds + 97280); LAS float* TOTS = (LAS float*)(lds + 105472);
    {
        const float bias = p.in(18)[h], a = -expf(p.in(19)[h]);
#pragma unroll 1
        for (int cc = wave; cc < 16; cc += 8) { const float tot = ssd_dt_scan(DT, (size_t)b * SEQ + cc * 128, h, bias, a, CS + cc * 128, DTV + cc * 128, lane); if (lane == 0) TOTS[cc] = tot; }
    }
    const float dsk0 = p.in(20)[h];
    const int pi = wave & 3, nj0 = (wave >> 2) * 4;
    const int tl = 16 * wave + (lane & 15);
    const bf16* Px = XC + (size_t)b * SEQ * 3072 + 64 * h + 8 * (tid & 7); const bf16* Pbb = XC + (size_t)b * SEQ * 3072 + 2048 + 128 * g + 8 * (tid & 15);
    const bf16* Pc = XC + ((size_t)b * SEQ + tl) * 3072 + 2560 + 128 * g + 8 * (lane >> 4);
    const bf16* Pz = P + ((size_t)b * SEQ + tl) * NAB + PZ + 64 * h + 4 * (lane >> 4);
    u32x4 rx[2], rb[4];
#define SSDF_LOAD(c_) { _Pragma("unroll") for (int i = 0; i < 2; ++i) rx[i] = *(const u32x4*)(Px + (size_t)((c_) * 128 + ((tid + 512 * i) >> 3)) * 3072); \
        _Pragma("unroll") for (int i = 0; i < 4; ++i) rb[i] = *(const u32x4*)(Pbb + (size_t)((c_) * 128 + ((tid + 512 * i) >> 4)) * 3072); }
    SSDF_LOAD(0)
    bf16x8 CFn[4]; u32x2 zwn[4];
#pragma unroll
    for (int ks = 0; ks < 4; ++ks) CFn[ks] = *(const bf16x8*)(Pc + 32 * ks);
#pragma unroll
    for (int pj = 0; pj < 4; ++pj) zwn[pj] = *(const u32x2*)(Pz + 16 * pj);
    f32x4 acc[4];
#pragma unroll
    for (int j = 0; j < 4; ++j) acc[j] = (f32x4){0.f, 0.f, 0.f, 0.f};
    __syncthreads();
#pragma unroll 1
    for (int c = 0; c < 16; ++c) {
        const size_t row0 = (size_t)b * SEQ + c * 128;
        const float tot = TOTS[c];
#pragma unroll
        for (int i = 0; i < 2; ++i) {
            const int s = (tid + 512 * i) >> 3; float o[8], ow[8]; unpack8(rx[i], o);
            const float dtv = DTV[c * 128 + s], w = __expf(tot - CS[c * 128 + s]);
#pragma unroll
            for (int e = 0; e < 8; ++e) { o[e] *= dtv; ow[e] = o[e] * w; }
            *(LAS u32x4*)(XD + s * 144 + (tid & 7) * 16) = pack8(o);
            *(LAS u32x4*)(XW + s * 144 + (tid & 7) * 16) = pack8(ow);
        }
#pragma unroll
        for (int i = 0; i < 4; ++i) *(LAS u32x4*)(BI + ((tid + 512 * i) >> 4) * 272 + (tid & 15) * 16) = rb[i];
#pragma unroll
        for (int j = 0; j < 4; ++j) { u32x2 w; w.x = pk2(acc[j][0], acc[j][1]); w.y = pk2(acc[j][2], acc[j][3]);
            *(LAS u32x2*)(HI + (16 * pi + (lane & 15)) * 272 + (16 * (nj0 + j) + 4 * (lane >> 4)) * 2) = w; }
        bf16x8 CF[4]; u32x2 zw[4];
#pragma unroll
        for (int ks = 0; ks < 4; ++ks) CF[ks] = CFn[ks];
#pragma unroll
        for (int pj = 0; pj < 4; ++pj) zw[pj] = zwn[pj];
        __syncthreads();
        if (c < 15) { SSDF_LOAD(c + 1)
#pragma unroll
            for (int ks = 0; ks < 4; ++ks) CFn[ks] = *(const bf16x8*)(Pc + (size_t)(c + 1) * 128 * 3072 + 32 * ks);
#pragma unroll
            for (int pj = 0; pj < 4; ++pj) zwn[pj] = *(const u32x2*)(Pz + (size_t)(c + 1) * 128 * NAB + 16 * pj); }
        int lq = lane >> 4; asm volatile("" : "+v"(lq));
        const float cst = CS[c * 128 + tl];
        f32x4 yT[4], yI[4];
#pragma unroll
        for (int pj = 0; pj < 4; ++pj) { yT[pj] = (f32x4){0.f, 0.f, 0.f, 0.f}; yI[pj] = (f32x4){0.f, 0.f, 0.f, 0.f}; }
#pragma unroll
        for (int ks = 0; ks < 4; ++ks) if (2 * ks <= wave) {
            f32x4 sa = (f32x4){0.f, 0.f, 0.f, 0.f}, sb = (f32x4){0.f, 0.f, 0.f, 0.f};
#pragma unroll
            for (int kk = 0; kk < 4; ++kk) {
                sa = mfma16(rowfrag(BI, 272, 32 * ks, 32 * kk, lane), CF[kk], sa);
                sb = mfma16(rowfrag(BI, 272, 32 * ks + 16, 32 * kk, lane), CF[kk], sb);
            }
            f32x4 pa, pb;
#pragma unroll
            for (int r = 0; r < 4; ++r) {
                const int s0 = 32 * ks + 4 * lq + r, s1 = s0 + 16;
                pa[r] = s0 <= tl ? sa[r] * __expf(cst - CS[c * 128 + s0]) : 0.f;
                pb[r] = s1 <= tl ? sb[r] * __expf(cst - CS[c * 128 + s1]) : 0.f;
            }
            const bf16x8 Pf = packP(pa, pb);
#pragma unroll
            for (int pj = 0; pj < 4; ++pj) yT[pj] = mfma16(trfragp(XD, 144, 32 * ks, 16 * pj, lane), Pf, yT[pj]);
        }
#pragma unroll
        for (int ks = 0; ks < 4; ++ks)
#pragma unroll
            for (int pj = 0; pj < 4; ++pj) yI[pj] = mfma16(rowfrag(HI, 272, 16 * pj, 32 * ks, lane), CF[ks], yI[pj]);
        {
            const float ecs = __expf(cst), dsk = dsk0 / DTV[c * 128 + tl];
            float ss = 0.f;
#pragma unroll
            for (int pj = 0; pj < 4; ++pj) {
                const int pc = 16 * pj + 4 * lq;
                const u32x2 xw = *(const LAS u32x2*)(XD + tl * 144 + pc * 2);
                const float xv[4] = {bflo(xw.x), bfhi(xw.x), bflo(xw.y), bfhi(xw.y)}, zv[4] = {bflo(zw[pj].x), bfhi(zw[pj].x), bflo(zw[pj].y), bfhi(zw[pj].y)};
                float yv[4];
#pragma unroll
                for (int r = 0; r < 4; ++r) { yv[r] = (yT[pj][r] + ecs * yI[pj][r] + dsk * xv[r]) * siluf(zv[r]); ss += yv[r] * yv[r]; }
                u32x2 yw; yw.x = pk2(yv[0], yv[1]); yw.y = pk2(yv[2], yv[3]);
                *(u32x2*)(Y + (row0 + tl) * 4096 + 64 * h + pc) = yw;
            }
            ss += __shfl_xor(ss, 16); ss += __shfl_xor(ss, 32);
            if (lane < 16) SSS[(row0 + tl) * 32 + h] = ss;
        }
        const float dec = __expf(tot);
#pragma unroll
        for (int j = 0; j < 4; ++j) acc[j] *= dec;
#pragma unroll
        for (int ks = 0; ks < 4; ++ks) {
            const bf16x8 Xf = trfrag(XW, 144, 32 * ks, 16 * pi, lane);
#pragma unroll
            for (int j = 0; j < 4; ++j) acc[j] = mfma16(trfrag(BI, 272, 32 * ks, 16 * (nj0 + j), lane), Xf, acc[j]);
        }
        __syncthreads();
    }
#undef SSDF_LOAD
    float* so = p.out + O_SSMP + ((size_t)(b * 32 + h) * 64) * 128;
#pragma unroll
    for (int j = 0; j < 4; ++j) *(f32x4*)(so + (16 * pi + (lane & 15)) * 128 + 16 * (nj0 + j) + 4 * (lane >> 4)) = acc[j];
}
__device__ __forceinline__ void norm_unit(const Ctx& p, int u) {
    const int tid = opaque_tid();
    bf16* Y = (bf16*)(p.ws + WS_R3); const float* RSS = (const float*)(p.ws + WS_RSS); const float* SSS = (const float*)(p.ws + WS_SSS);
    const int cg = tid;
    const float* stat = (cg < 256 ? SSS : RSS) + 8 * ((cg >> 6) & 3);
#pragma unroll 4
    for (int r = 0; r < 64; ++r) {
        const size_t row = (size_t)u * 64 + r;
        const f32x4 s0 = *(const f32x4*)(stat + row * 32), s1 = *(const f32x4*)(stat + row * 32 + 4);
        const float rstd = rsqrtf(((s0.x + s0.y) + (s0.z + s0.w) + (s1.x + s1.y) + (s1.z + s1.w)) * (1.f / 512.f) + 1e-6f);
        u32x4* yp = (u32x4*)(Y + row * 4096 + 8 * cg);
        float v[8]; unpack8(*yp, v);
#pragma unroll
        for (int e = 0; e < 8; ++e) v[e] *= rstd;
        *yp = pack8(v);
    }
}
constexpr float KSC = 0.08838834764831845f;
constexpr int CCR = 272;

__device__ __forceinline__ float mlstm_gates(const float* GT, size_t row0, int h, float ib, float fb, int lane, float& b0, float& b1, float& g0, float& g1) {
    const int s0 = 2 * lane;
    const float i0 = GT[(row0 + s0) * 8 + h] + ib, i1 = GT[(row0 + s0 + 1) * 8 + h] + ib;
    const float l0 = logsigf(GT[(row0 + s0) * 8 + 4 + h] + fb), l1 = logsigf(GT[(row0 + s0 + 1) * 8 + 4 + h] + fb);
    float v = l0 + l1;
#pragma unroll
    for (int o = 1; o < 64; o <<= 1) { const float t = __shfl_up(v, o); if (lane >= o) v += t; }
    b0 = v - l1; b1 = v; g0 = i0 - b0; g1 = i1 - b1;
    return __shfl(v, 63);
}

__device__ __forceinline__ void mlA_unit(const Ctx& p, ldsp lds, int b, int h, int dvs) {
    const int tid = opaque_tid(), lane = tid & 63, wave = __builtin_amdgcn_readfirstlane(tid >> 6);
    unsigned char* ws = p.ws;
    const bf16* P2 = (const bf16*)(ws + WS_P); const float* GT = (const float*)(ws + WS_DT); bf16* CC = (bf16*)(ws + WS_SC); float* MCH = (float*)(ws + WS_MCH);
    ldsp KW = lds; ldsp VI = lds + 34816; LAS float* GV = (LAS float*)(lds + 49152); LAS float* BT = GV + 2048; LAS float* GM = BT + 16; LAS float* MS = GM + 16; LAS float* DP = MS + 32;
    {
        const float ib = p.in(24)[h], fb = p.in(25)[h];
#pragma unroll 1
        for (int cc = wave; cc < 16; cc += 8) {
            float b0, b1, g0, g1; const float btot = mlstm_gates(GT, (size_t)b * SEQ + cc * 128, h, ib, fb, lane, b0, b1, g0, g1);
            const float gmax = wave_max(fmaxf(g0, g1));
            GV[cc * 128 + 2 * lane] = g0; GV[cc * 128 + 2 * lane + 1] = g1;
            if (lane == 0) { BT[cc] = btot; GM[cc] = gmax; }
        }
    }
    const bf16* Pk = P2 + (size_t)b * SEQ * NC + CK + 128 * h + 8 * (tid & 15); const bf16* Pv = P2 + (size_t)b * SEQ * NC + CV + 256 * h + 32 * dvs + 8 * (tid & 3);
    const int vcg = tid & 7;
    u32x4 rk[4], rv[2];
#pragma unroll
    for (int i = 0; i < 4; ++i) rk[i] = *(const u32x4*)(Pk + (size_t)((tid + 512 * i) >> 4) * NC);
#pragma unroll
    for (int i = 0; i < 2; ++i) rv[i] = *(const u32x4*)(Pv + (size_t)((tid + 512 * i) >> 3) * NC);
    __syncthreads();
    if (tid == 0) {
        float m = 0.f;
        for (int cc = 0; cc < 16; ++cc) { const float mn = BT[cc] + fmaxf(m, GM[cc]); MS[cc] = m; DP[cc] = __expf(BT[cc] + m - mn); if (dvs == 0) MCH[(b * 4 + h) * 16 + cc] = m; m = mn; }
        MS[16] = m;
    }
    f32x4 acc[3];
#pragma unroll
    for (int j = 0; j < 3; ++j) acc[j] = (f32x4){0.f, 0.f, 0.f, 0.f};
    __syncthreads();
#pragma unroll 1
    for (int c = 0; c < 16; ++c) {
        const float bm = BT[c] - MS[c + 1];
#pragma unroll
        for (int i = 0; i < 4; ++i) {
            const int s = (tid + 512 * i) >> 4; float k[8]; unpack8(rk[i], k);
            const float w = KSC * __expf(GV[c * 128 + s] + bm);
#pragma unroll
            for (int e = 0; e < 8; ++e) k[e] *= w;
            *(LAS u32x4*)(KW + s * 272 + (tid & 15) * 16) = pack8(k);
        }
#pragma unroll
        for (int i = 0; i < 2; ++i) {
            const int s = (tid + 512 * i) >> 3;
            unsigned zz = 0u; asm volatile("" : "+v"(zz));
            if (vcg < 4) *(LAS u32x4*)(VI + s * 112 + vcg * 16) = rv[i];
            else if (vcg == 4) *(LAS u32x4*)(VI + s * 112 + 64) = (u32x4){zz | 0x3F80u, zz, zz, zz};
            else if (vcg == 5) *(LAS u32x4*)(VI + s * 112 + 80) = (u32x4){zz, zz, zz, zz};
        }
        __syncthreads();
        if (c < 15) {
#pragma unroll
            for (int i = 0; i < 4; ++i) rk[i] = *(const u32x4*)(Pk + (size_t)((c + 1) * 128 + ((tid + 512 * i) >> 4)) * NC);
#pragma unroll
            for (int i = 0; i < 2; ++i) rv[i] = *(const u32x4*)(Pv + (size_t)((c + 1) * 128 + ((tid + 512 * i) >> 3)) * NC);
        }
        {
            bf16* cc = CC + (((size_t)(b * 4 + h) * 16 + c) * CCR) * 128;
            const int dk0 = 16 * wave + 4 * (lane >> 4);
#pragma unroll
            for (int j = 0; j < 2; ++j) { u32x2 w; w.x = pk2(acc[j][0], acc[j][1]); w.y = pk2(acc[j][2], acc[j][3]); *(u32x2*)(cc + (size_t)(32 * dvs + 16 * j + (lane & 15)) * 128 + dk0) = w; }
            if (dvs == 0) { u32x2 w; w.x = pk2(acc[2][0], acc[2][1]); w.y = pk2(acc[2][2], acc[2][3]); *(u32x2*)(cc + (size_t)(256 + (lane & 15)) * 128 + dk0) = w; }
        }
        const float dp = DP[c];
#pragma unroll
        for (int j = 0; j < 3; ++j) acc[j] *= dp;
#pragma unroll
        for (int ks = 0; ks < 4; ++ks) {
            const bf16x8 A = trfrag(KW, 272, 32 * ks, 16 * wave, lane);
#pragma unroll
            for (int j = 0; j < 3; ++j) acc[j] = mfma16(A, trfrag(VI, 112, 32 * ks, 16 * j, lane), acc[j]);
        }
        __syncthreads();
    }
    float* co = p.out + O_MCP + ((size_t)(b * 4 + h) * 128) * 256;
#pragma unroll
    for (int j = 0; j < 2; ++j)
#pragma unroll
        for (int r = 0; r < 4; ++r) co[(size_t)(16 * wave + 4 * (lane >> 4) + r) * 256 + 32 * dvs + 16 * j + (lane & 15)] = acc[j][r];
    if (dvs == 0) {
        if ((lane & 15) == 0) {
#pragma unroll
            for (int r = 0; r < 4; ++r) p.out[O_MNP + (size_t)(b * 4 + h) * 128 + 16 * wave + 4 * (lane >> 4) + r] = acc[2][r];
        }
        if (tid == 0) p.out[O_MMP + b * 4 + h] = MS[16];
    }
    __syncthreads();
}

__device__ __forceinline__ void mlB_unit(const Ctx& p, ldsp lds, int b, int h, int c) {
    const int tid = opaque_tid(), lane = tid & 63, wave = __builtin_amdgcn_readfirstlane(tid >> 6);
    unsigned char* ws = p.ws;
    const bf16* P2 = (const bf16*)(ws + WS_P); const float* GT = (const float*)(ws + WS_DT); const bf16* CC = (const bf16*)(ws + WS_SC); const float* MCH = (const float*)(ws + WS_MCH);
    bf16* Y2 = (bf16*)(ws + WS_R3);
    ldsp KI = lds; ldsp VI = lds + 34816; LAS float* GB = (LAS float*)(lds + 102400); LAS float* GG = GB + 128; LAS float* MT = GG + 128;
    const size_t row0 = (size_t)b * SEQ + c * 128;
    const float mc = MCH[(b * 4 + h) * 16 + c];
    if (wave == 0) {
        float b0, b1, g0, g1; (void)mlstm_gates(GT, row0, h, p.in(24)[h], p.in(25)[h], lane, b0, b1, g0, g1);
        float v = fmaxf(g0, g1);
#pragma unroll
        for (int o = 1; o < 64; o <<= 1) { const float t = __shfl_up(v, o); if (lane >= o) v = fmaxf(v, t); }
        float prev = __shfl_up(v, 1); if (lane == 0) prev = -3.0e38f;
        const float M0 = fmaxf(prev, g0), M1 = fmaxf(M0, g1);
        GB[2 * lane] = b0; GB[2 * lane + 1] = b1; GG[2 * lane] = g0; GG[2 * lane + 1] = g1;
        MT[2 * lane] = b0 + fmaxf(mc, M0); MT[2 * lane + 1] = b1 + fmaxf(mc, M1);
    }
#pragma unroll
    for (int i = 0; i < 4; ++i) {
        const int id = tid + 512 * i, s = id >> 4, cg = id & 15; float k[8];
        unpack8(*(const u32x4*)(P2 + (row0 + s) * NC + CK + 128 * h + 8 * cg), k);
#pragma unroll
        for (int e = 0; e < 8; ++e) k[e] *= KSC;
        *(LAS u32x4*)(KI + s * 272 + cg * 16) = pack8(k);
    }
#pragma unroll
    for (int i = 0; i < 8; ++i) {
        const int id = tid + 512 * i, s = id >> 5, cg = id & 31;
        *(LAS u32x4*)(VI + s * 528 + cg * 16) = *(const u32x4*)(P2 + (row0 + s) * NC + CV + 256 * h + 8 * cg);
    }
    __syncthreads();
    const int tl = 16 * wave + (lane & 15);
    const float bt = GB[tl], mt = MT[tl], inter = __expf(bt + mc - mt);
    bf16x8 QF[4], QF2[4];
#pragma unroll
    for (int ks = 0; ks < 4; ++ks) {
        QF[ks] = gfrag(P2 + CQ + 128 * h, NC, (int)row0 + 16 * wave, 32 * ks, lane);
        float q[8]; unpack8(__builtin_bit_cast(u32x4, QF[ks]), q);
#pragma unroll
        for (int e = 0; e < 8; ++e) q[e] *= inter;
        QF2[ks] = __builtin_bit_cast(bf16x8, pack8(q));
    }
    f32x4 ST[8];
#pragma unroll
    for (int sj = 0; sj < 8; ++sj) ST[sj] = (f32x4){0.f, 0.f, 0.f, 0.f};
#pragma unroll
    for (int sj = 0; sj < 8; ++sj) if (sj <= wave) {
#pragma unroll
        for (int ks = 0; ks < 4; ++ks) ST[sj] = mfma16(rowfrag(KI, 272, 16 * sj, 32 * ks, lane), QF[ks], ST[sj]);
    }
    bf16x8 PF[4]; float asum = 0.f;
#pragma unroll
    for (int ks = 0; ks < 4; ++ks) {
        f32x4 pa, pb;
#pragma unroll
        for (int r = 0; r < 4; ++r) {
            const int s0 = 32 * ks + 4 * (lane >> 4) + r, s1 = s0 + 16;
            pa[r] = s0 <= tl ? ST[2 * ks][r] * __expf(GG[s0] + bt - mt) : 0.f;
            pb[r] = s1 <= tl ? ST[2 * ks + 1][r] * __expf(GG[s1] + bt - mt) : 0.f;
            asum += pa[r] + pb[r];
        }
        PF[ks] = packP(pa, pb);
    }
    asum += __shfl_xor(asum, 16); asum += __shfl_xor(asum, 32);
    const bf16* cc = CC + (((size_t)(b * 4 + h) * 16 + c) * CCR) * 128;
    f32x4 nT[16];
    bf16x8 CFr[3][4];
#pragma unroll
    for (int ks = 0; ks < 4; ++ks) { CFr[0][ks] = gfrag(cc, 128, 0, 32 * ks, lane); CFr[1][ks] = gfrag(cc, 128, 16, 32 * ks, lane); }
#pragma unroll
    for (int dj = 0; dj < 16; ++dj) {
#pragma unroll
        for (int ks = 0; ks < 4; ++ks) CFr[(dj + 2) % 3][ks] = gfrag(cc, 128, 16 * (dj + 2), 32 * ks, lane);
        nT[dj] = (f32x4){0.f, 0.f, 0.f, 0.f};
#pragma unroll
        for (int ks = 0; ks < 4; ++ks) if (2 * ks <= wave) nT[dj] = mfma16(trfragp(VI, 528, 32 * ks, 16 * dj, lane), PF[ks], nT[dj]);
#pragma unroll
        for (int ks = 0; ks < 4; ++ks) nT[dj] = mfma16(CFr[dj % 3][ks], QF2[ks], nT[dj]);
    }
    f32x4 dn = (f32x4){0.f, 0.f, 0.f, 0.f};
#pragma unroll
    for (int ks = 0; ks < 4; ++ks) dn = mfma16(CFr[16 % 3][ks], QF2[ks], dn);
    const float qn = __shfl(dn[0], lane & 15);
    const float den = asum + qn;
    const float hdiv = 1.f / fmaxf(fabsf(den), __expf(-mt));
    float ss = 0.f;
#pragma unroll
    for (int dj = 0; dj < 16; ++dj)
#pragma unroll
        for (int r = 0; r < 4; ++r) { nT[dj][r] *= hdiv; ss += nT[dj][r] * nT[dj][r]; }
    ss += __shfl_xor(ss, 16); ss += __shfl_xor(ss, 32);
    const float rstd = rsqrtf(ss * (1.f / 256.f) + 1e-6f);
    u32x2 owv[16];
#pragma unroll
    for (int dj = 0; dj < 16; ++dj) owv[dj] = *(const u32x2*)(P2 + (row0 + tl) * NC + CO + 256 * h + 16 * dj + 4 * (lane >> 4));
#pragma unroll
    for (int dj = 0; dj < 16; ++dj) {
        const int dv = 16 * dj + 4 * (lane >> 4);
        const u32x2 ow = owv[dj];
        u32x2 w; w.x = pk2(sigmf(bflo(ow.x)) * nT[dj][0] * rstd, sigmf(bfhi(ow.x)) * nT[dj][1] * rstd);
        w.y = pk2(sigmf(bflo(ow.y)) * nT[dj][2] * rstd, sigmf(bfhi(ow.y)) * nT[dj][3] * rstd);
        *(u32x2*)(Y2 + (row0 + tl) * 1024 + 256 * h + dv) = w;
    }
    __syncthreads();
}

__device__ __forceinline__ void mlS_unit(const Ctx& p, ldsp lds, int b, int h) {
    const int tid = opaque_tid(), lane = tid & 63, wave = __builtin_amdgcn_readfirstlane(tid >> 6);
    unsigned char* ws = p.ws;
    const bf16* P2 = (const bf16*)(ws + WS_P); const float* GT = (const float*)(ws + WS_DT); bf16* Y2 = (bf16*)(ws + WS_R3);
    const size_t row = NP + b;
    LAS float* QS = (LAS float*)lds; LAS float* KS = QS + 128; LAS float* VS = KS + 128; LAS float* RD = VS + 256; LAS float* RED = RD + 2048; LAS float* DEN = RED + 8;
    const int dvq = tid & 63, dkg = tid >> 6;
    const size_t sb = ((size_t)(b * 4 + h) * 128) * 256 + 4 * dvq;
    const float* si = p.in(7) + sb; float* so = p.out + O_MCS + sb;
    f32x4 s[16];
#pragma unroll
    for (int i = 0; i < 16; ++i) s[i] = ldnt4(si + (size_t)(dkg + 8 * i) * 256);
    const float ig = GT[row * 8 + h] + p.in(24)[h], lf = logsigf(GT[row * 8 + 4 + h] + p.in(25)[h]);
    const float m0 = p.in(9)[b * 4 + h];
    const float mn = fmaxf(lf + m0, ig), fp = expf(lf + m0 - mn), ip = expf(ig - mn);
    float dpart = 0.f;
    if (tid < 128) {
        const float q = bf2f(P2[row * NC + CQ + 128 * h + tid]), k = bf2f(P2[row * NC + CK + 128 * h + tid]) * KSC;
        const float nn = fp * p.in(8)[(size_t)(b * 4 + h) * 128 + tid] + ip * k;
        p.out[O_MNS + (size_t)(b * 4 + h) * 128 + tid] = nn;
        QS[tid] = q; KS[tid] = k; dpart = q * nn;
    }
    if (tid < 256) VS[tid] = bf2f(P2[row * NC + CV + 256 * h + tid]);
    if (tid == 0) p.out[O_MMS + b * 4 + h] = mn;
    const float den = block_sum8(dpart, RED, lane, wave);
    const f32x4 v4 = *(const LAS f32x4*)(VS + 4 * dvq);
    f32x4 n4 = (f32x4){0.f, 0.f, 0.f, 0.f};
#pragma unroll
    for (int i = 0; i < 16; ++i) {
        const int dk = dkg + 8 * i;
        const f32x4 cn = fp * s[i] + (ip * KS[dk]) * v4;
        stnt4(so + (size_t)dk * 256, cn);
        n4 += QS[dk] * cn;
    }
    *(LAS f32x4*)(RD + dkg * 256 + 4 * dvq) = n4;
    __syncthreads();
    float hv = 0.f;
    if (tid < 256) { float num = 0.f;
#pragma unroll
        for (int j = 0; j < 8; ++j) num += RD[j * 256 + tid];
        hv = num / fmaxf(fabsf(den), expf(-mn)); }
    const float tot = block_sum8(hv * hv, RED, lane, wave);
    if (tid < 256) { const float o = bf2f(P2[row * NC + CO + 256 * h + tid]);
        Y2[row * 1024 + 256 * h + tid] = (bf16)(pk2(sigmf(o) * hv * rsqrtf(tot * (1.f / 256.f) + 1e-6f), 0.f) & 0xffffu); }
    __syncthreads();
}

__device__ __forceinline__ void xaP_unit(const Ctx& p, ldsp lds, int layer, int b, int h, int qt) {
    const int tid = opaque_tid(), lane = tid & 63, wave = __builtin_amdgcn_readfirstlane(tid >> 6);
    unsigned char* ws = p.ws;
    const bf16* Q = (const bf16*)(ws + WS_R3); bf16* O = (bf16*)(ws + WS_R3 + (size_t)MP * 1024 * 2);
    const bf16* KB = (const bf16*)(ws + WS_KB) + (size_t)layer * 2048 * 1024 + (size_t)b * 256 * 1024 + 256 * h;
    const bf16* VB = (const bf16*)(ws + WS_VB) + (size_t)layer * 2048 * 1024 + (size_t)b * 256 * 1024 + 256 * h;
    const int row0 = b * SEQ + 128 * qt + 16 * wave;
    const size_t toff = (size_t)(tid >> 5) * 1024 + 8 * (tid & 31);
    u32x4 rq[4];
#pragma unroll
    for (int i = 0; i < 4; ++i) rq[i] = *(const u32x4*)(KB + toff + (size_t)i * 16 * 1024);
    bf16x8 QF[8];
#pragma unroll
    for (int ks = 0; ks < 8; ++ks) QF[ks] = gfrag(Q + 256 * h, 1024, row0, 32 * ks, lane);
    f32x4 ST[16];
    bf16x8 PF[8];
    f32x4 OT[16];
#pragma unroll
    for (int dj = 0; dj < 16; ++dj) OT[dj] = (f32x4){0.f, 0.f, 0.f, 0.f};
    float sum = 0.f;
#pragma unroll
    for (int q = 0; q < 8; ++q) {
        ldsp KQ = lds + (q & 1) * 33792;
#pragma unroll
        for (int i = 0; i < 4; ++i) *(LAS u32x4*)(KQ + ((tid >> 5) + 16 * i) * 528 + (tid & 31) * 16) = rq[i];
        __syncthreads();
        if (q < 7) {
            const bf16* src = (q + 1 < 4) ? KB + (size_t)(64 * (q + 1)) * 1024 : VB + (size_t)(64 * (q + 1 - 4)) * 1024;
#pragma unroll
            for (int i = 0; i < 4; ++i) rq[i] = *(const u32x4*)(src + toff + (size_t)i * 16 * 1024);
        }
        if (q < 4) {
#pragma unroll
            for (int j = 0; j < 4; ++j) {
                ST[4 * q + j] = (f32x4){0.f, 0.f, 0.f, 0.f};
#pragma unroll
                for (int ks = 0; ks < 8; ++ks) ST[4 * q + j] = mfma16(rowfrag(KQ, 528, 16 * j, 32 * ks, lane), QF[ks], ST[4 * q + j]);
            }
            if (q == 3) {
                float mx = -3.0e38f;
#pragma unroll
                for (int mj = 0; mj < 16; ++mj)
#pragma unroll
                    for (int r = 0; r < 4; ++r) mx = fmaxf(mx, ST[mj][r]);
                mx = fmaxf(mx, __shfl_xor(mx, 16)); mx = fmaxf(mx, __shfl_xor(mx, 32));
#pragma unroll
                for (int mj = 0; mj < 16; ++mj)
#pragma unroll
                    for (int r = 0; r < 4; ++r) { const float e = __expf((ST[mj][r] - mx) * 0.0625f); ST[mj][r] = e; sum += e; }
                sum += __shfl_xor(sum, 16); sum += __shfl_xor(sum, 32);
#pragma unroll
                for (int k2 = 0; k2 < 8; ++k2) PF[k2] = packP(ST[2 * k2], ST[2 * k2 + 1]);
            }
        } else {
            const int qv = q - 4;
#pragma unroll
            for (int dj = 0; dj < 16; ++dj)
#pragma unroll
                for (int kk = 0; kk < 2; ++kk) OT[dj] = mfma16(trfragp(KQ, 528, 32 * kk, 16 * dj, lane), PF[2 * qv + kk], OT[dj]);
        }
    }
    const float inv = 1.f / sum;
    const int row = row0 + (lane & 15);
#pragma unroll
    for (int dj = 0; dj < 16; ++dj) { u32x2 w; w.x = pk2(OT[dj][0] * inv, OT[dj][1] * inv); w.y = pk2(OT[dj][2] * inv, OT[dj][3] * inv);
        *(u32x2*)(O + (size_t)row * 1024 + 256 * h + 16 * dj + 4 * (lane >> 4)) = w; }
    __syncthreads();
}
__device__ __forceinline__ void xaS_unit(const Ctx& p, ldsp lds, int layer, int b, int h) {
    const int tid = opaque_tid(), lane = tid & 63, wave = __builtin_amdgcn_readfirstlane(tid >> 6);
    unsigned char* ws = p.ws;
    const bf16* Q = (const bf16*)(ws + WS_R3); bf16* O = (bf16*)(ws + WS_R3 + (size_t)MP * 1024 * 2);
    const size_t row = NP + b;
    const float* Kc = p.in(2) + ((size_t)(layer * 128 + b) * 256) * 1024 + 256 * h; const float* Vc = p.in(3) + ((size_t)(layer * 128 + b) * 256) * 1024 + 256 * h;
    LAS float* QS = (LAS float*)lds; LAS float* SC = QS + 256; LAS float* RD = SC + 256; LAS float* RED = RD + 2048;
    if (tid < 256) QS[tid] = bf2f(Q[row * 1024 + 256 * h + tid]);
    __syncthreads();
    const f32x4 q4 = *(const LAS f32x4*)(QS + 4 * lane);
#pragma unroll 1
    for (int i0 = 0; i0 < 32; i0 += 16) {
        f32x4 kr[16];
#pragma unroll
        for (int i = 0; i < 16; ++i) kr[i] = ldnt4(Kc + (size_t)(wave + 8 * (i0 + i)) * 1024 + 4 * lane);
#pragma unroll
        for (int i = 0; i < 16; ++i) {
            const float s = wave_sum((kr[i].x * q4.x + kr[i].y * q4.y) + (kr[i].z * q4.z + kr[i].w * q4.w));
            if (lane == 0) SC[wave + 8 * (i0 + i)] = s * 0.0625f;
        }
    }
    f32x4 vpre[32];
#pragma unroll
    for (int i = 0; i < 32; ++i) vpre[i] = ldnt4(Vc + (size_t)(wave + 8 * i) * 1024 + 4 * lane);
    __syncthreads();
    const float sv = tid < 256 ? SC[tid] : -3.0e38f;
    float mx = wave_max(sv);
    __syncthreads();
    if (lane == 0) RED[wave] = mx;
    __syncthreads();
    mx = fmaxf(fmaxf(fmaxf(RED[0], RED[1]), fmaxf(RED[2], RED[3])), fmaxf(fmaxf(RED[4], RED[5]), fmaxf(RED[6], RED[7])));
    const float e = tid < 256 ? __expf(sv - mx) : 0.f;
    const float tot = block_sum8(e, RED, lane, wave);
    if (tid < 256) SC[tid] = e / tot;
    __syncthreads();
    f32x4 o4 = (f32x4){0.f, 0.f, 0.f, 0.f};
#pragma unroll
    for (int i = 0; i < 32; ++i) o4 += SC[wave + 8 * i] * vpre[i];
    *(LAS f32x4*)(RD + wave * 256 + 4 * lane) = o4;
    __syncthreads();
    if (tid < 256) { float o = 0.f;
#pragma unroll
        for (int j = 0; j < 8; ++j) o += RD[j * 256 + tid];
        O[row * 1024 + 256 * h + tid] = (bf16)(pk2(o, 0.f) & 0xffffu); }
    __syncthreads();
}

__device__ __forceinline__ void xaS2_unit(const Ctx& p, ldsp lds, int layer, int b, int hp) {
    const int tid = opaque_tid(), lane = tid & 63, wave = __builtin_amdgcn_readfirstlane(tid >> 6);
    unsigned char* ws = p.ws;
    const bf16* Q = (const bf16*)(ws + WS_R3); bf16* O = (bf16*)(ws + WS_R3 + (size_t)MP * 1024 * 2);
    const size_t row = NP + b;
    const float* Kc = p.in(2) + ((size_t)(layer * 128 + b) * 256) * 1024 + 512 * hp + 4 * lane; const float* Vc = p.in(3) + ((size_t)(layer * 128 + b) * 256) * 1024 + 512 * hp + 4 * lane;
    LAS float* QS = (LAS float*)lds; LAS float* SC = QS + 512; LAS float* RD = SC + 512; LAS float* RED = RD + 4096;
    QS[tid] = bf2f(Q[row * 1024 + 512 * hp + tid]);
    __syncthreads();
    const f32x4 qa = *(const LAS f32x4*)(QS + 4 * lane), qb = *(const LAS f32x4*)(QS + 256 + 4 * lane);
#pragma unroll 1
    for (int i0 = 0; i0 < 32; i0 += 8) {
        f32x4 ka[8], kb[8];
#pragma unroll
        for (int i = 0; i < 8; ++i) { const float* kr = Kc + (size_t)(wave + 8 * (i0 + i)) * 1024; ka[i] = ldnt4(kr); kb[i] = ldnt4(kr + 256); }
#pragma unroll
        for (int i = 0; i < 8; ++i) {
            const float sa = wave_sum((ka[i].x * qa.x + ka[i].y * qa.y) + (ka[i].z * qa.z + ka[i].w * qa.w));
            const float sb = wave_sum((kb[i].x * qb.x + kb[i].y * qb.y) + (kb[i].z * qb.z + kb[i].w * qb.w));
            if (lane == 0) { SC[wave + 8 * (i0 + i)] = sa * 0.0625f; SC[256 + wave + 8 * (i0 + i)] = sb * 0.0625f; }
        }
    }
    f32x4 va[16], vb[16];
#pragma unroll
    for (int i = 0; i < 16; ++i) { const float* vr = Vc + (size_t)(wave + 8 * i) * 1024; va[i] = ldnt4(vr); vb[i] = ldnt4(vr + 256); }
    __syncthreads();
    const float sv = SC[tid];
    float mx = wave_max(sv);
    __syncthreads();
    if (lane == 0) RED[wave] = mx;
    __syncthreads();
    { const int w0 = wave & 4; mx = fmaxf(fmaxf(RED[w0], RED[w0 + 1]), fmaxf(RED[w0 + 2], RED[w0 + 3])); }
    const float e = __expf(sv - mx);
    float es = wave_sum(e);
    __syncthreads();
    if (lane == 0) RED[wave] = es;
    __syncthreads();
    { const int w0 = wave & 4; es = (RED[w0] + RED[w0 + 1]) + (RED[w0 + 2] + RED[w0 + 3]); }
    SC[tid] = e * __builtin_amdgcn_rcpf(es);
    __syncthreads();
    f32x4 oa = (f32x4){0.f, 0.f, 0.f, 0.f}, ob = (f32x4){0.f, 0.f, 0.f, 0.f};
#pragma unroll
    for (int i = 0; i < 16; ++i) { oa += SC[wave + 8 * i] * va[i]; ob += SC[256 + wave + 8 * i] * vb[i]; }
#pragma unroll 1
    for (int i0 = 16; i0 < 32; i0 += 8) {
#pragma unroll
        for (int i = 0; i < 8; ++i) { const float* vr = Vc + (size_t)(wave + 8 * (i0 + i)) * 1024; va[i] = ldnt4(vr); vb[i] = ldnt4(vr + 256); }
#pragma unroll
        for (int i = 0; i < 8; ++i) { oa += SC[wave + 8 * (i0 + i)] * va[i]; ob += SC[256 + wave + 8 * (i0 + i)] * vb[i]; }
    }
    *(LAS f32x4*)(RD + wave * 512 + 4 * lane) = oa; *(LAS f32x4*)(RD + wave * 512 + 256 + 4 * lane) = ob;
    __syncthreads();
    { float o = 0.f;
#pragma unroll
      for (int j = 0; j < 8; ++j) o += RD[j * 512 + tid];
      O[row * 1024 + 512 * hp + tid] = (bf16)(pk2(o, 0.f) & 0xffffu); }
    __syncthreads();
}

__device__ __forceinline__ void final_norm(const Ctx& p, int vcu, int G) {
    const int tid = opaque_tid(), lane = tid & 63, wave = tid >> 6;
    const bf16* XB = (const bf16*)(p.ws + WS_XB); const float* gn = p.in(36);
    const int NGW = G * 8;
    f32x4 gv[2][2];
#pragma unroll
    for (int j = 0; j < 2; ++j) { gv[j][0] = *(const f32x4*)(gn + 512 * j + 8 * lane); gv[j][1] = *(const f32x4*)(gn + 512 * j + 8 * lane + 4); }
    for (int row = vcu * 8 + wave; row < MR; row += 2 * NGW) {
        u32x4 raw[2][2];
#pragma unroll
        for (int q = 0; q < 2; ++q) { const int r = row + q * NGW < MR ? row + q * NGW : row; const u32x4* src = (const u32x4*)(XB + (size_t)r * D) + lane; raw[q][0] = src[0]; raw[q][1] = src[64]; }
#pragma unroll
        for (int q = 0; q < 2; ++q) if (row + q * NGW < MR) {
            float v[2][8]; float ss = 0.f;
#pragma unroll
            for (int j = 0; j < 2; ++j) { unpack8(raw[q][j], v[j]);
#pragma unroll
                for (int e = 0; e < 8; ++e) ss += v[j][e] * v[j][e]; }
            const float rstd = rsqrtf(wave_sum(ss) * (1.f / 1024.f) + 1e-6f);
#pragma unroll
            for (int j = 0; j < 2; ++j) {
                float* dst = p.out + (size_t)(row + q * NGW) * D + 512 * j + 8 * lane;
                *(f32x4*)dst = (f32x4){v[j][0] * rstd * gv[j][0].x, v[j][1] * rstd * gv[j][0].y, v[j][2] * rstd * gv[j][0].z, v[j][3] * rstd * gv[j][0].w};
                *(f32x4*)(dst + 4) = (f32x4){v[j][4] * rstd * gv[j][1].x, v[j][5] * rstd * gv[j][1].y, v[j][6] * rstd * gv[j][1].z, v[j][7] * rstd * gv[j][1].w};
            }
        }
    }
}
constexpr int LDS_BYTES = 148480;

template <class Epi, bool ALIGN = true>
__device__ __forceinline__ void run_gemm(ldsp lds, const bf16* A, const bf16* Bt, int M, int N, int K, int G, int c, const Epi& E) {
    pg8::Gemm g{A, Bt, M, N, K}; pg8::StaticOrder S; S.init(M, N, G, c);
    pg8::gemm_phase<Epi, pg8::StaticOrder, ALIGN, true>(lds, g, S, E);
}

template <unsigned MASK>
__global__ void __launch_bounds__(512, 2) mega_fwd(Params kp) {
    extern __shared__ __attribute__((aligned(16))) unsigned char lds_raw[];
    ldsp lds = (ldsp)lds_raw;
    {
        const int tid = threadIdx.x;
        for (int u = tid; u < 64; u += 512) ((LAS unsigned*)(lds + LDSCTL_OFF))[u] = 0u;
        if (tid < 37) ((LAS unsigned long long*)(lds + LDS_INTAB))[tid] = (unsigned long long)kp.in[tid];
        if (tid == 37) ((LAS unsigned long long*)(lds + LDS_INTAB))[37] = (unsigned long long)kp.out;
        if (tid == 38) ((LAS unsigned long long*)(lds + LDS_INTAB))[38] = (unsigned long long)kp.ws;
        __syncthreads();
        (void)xcd_barrier_post((unsigned*)(kp.ws + WS_CTL), (volatile LAS unsigned*)(lds + LDSCTL_OFF + 64));
    }
#define PH_BEGIN { Ctx p; p.lds = lds; p.ws = (unsigned char*)p.in(38); p.out = (float*)p.in(37); unsigned char* ws = p.ws; int G = gridDim.x, bx = blockIdx.x; asm volatile("" : "+s"(G), "+s"(bx)); (void)ws; (void)G; (void)bx;
#define PH_END   { XcdBarrier bar_; bar_.bar = (unsigned*)(p.ws + WS_CTL); bar_.x = xb_xcc_id(); bar_.st = (volatile LAS unsigned*)(lds + LDSCTL_OFF + 64); xcd_barrier(bar_); } }
#define PH_END_NOBAR }
#define XB_ ((bf16*)(ws + WS_XB))
#define X_ ((float*)(ws + WS_X))
#define SLOT_ ((float*)(ws + WS_SLOT))
#define R3_ ((bf16*)(ws + WS_R3))
#define OB_ ((bf16*)(ws + WS_R3 + (size_t)MP * 1024 * 2))
#define PB_ ((bf16*)(ws + WS_P))
#define DTB_ ((float*)(ws + WS_DT))

    PH_BEGIN
        const int vcu = (G % 8 == 0) ? (bx % 8) * (G / 8) + bx / 8 : bx;
        if constexpr ((MASK & 1u) != 0) { prologue<(MASK >> 24) & 7u>(p, lds, vcu, G); if constexpr ((MASK & 0x4000000u) != 0) prologue_mem(p, vcu, G); }
    PH_END
#pragma unroll 1
    for (int layer = 0; layer < 2; ++layer) {
        PH_BEGIN { EpiSwiglu E{R3_, SLOT_, (MASK & 0x10000000u) ? 0 : 1}; if constexpr ((MASK & 2u) != 0) run_gemm(lds, XB_, (const bf16*)(ws + WS_W1IN + layer * SZ_WIN), MP, 5632, 1024, G, bx, E); }
            if constexpr ((MASK & 0x1000001u) == 0x1000001u) { const int nact = 1430 - (1430 / G) * G; if (nact > 0 && bx >= nact) { __syncthreads(); if (layer == 0) convert_set<1>(p, lds, bx - nact, G - nact); else convert_set<3>(p, lds, bx - nact, G - nact); } } PH_END
        PH_BEGIN if constexpr ((MASK & 16384u) != 0) { EpiResid E{layer == 0 ? p.in(0) : (const float*)nullptr, XB_, SLOT_, 0.5f}; run_gemm(lds, R3_, (const bf16*)(ws + WS_W1OUT + layer * SZ_WOUT), NP, 1024, FF, G, bx, E);
            if constexpr ((MASK & 0x8000000u) != 0) if (bx < 128) { ThinResid T{layer == 0 ? p.in(1) - (size_t)NP * D : (const float*)nullptr, XB_, SLOT_, 0.5f}; thin_gemm(lds, R3_, (const bf16*)(ws + WS_W1OUT + layer * SZ_WOUT), FF, bx, T); } } PH_END
        if (layer == 0) {
            PH_BEGIN if constexpr ((MASK & 32768u) != 0) { { EpiScaleG E{PB_, NAB, 44, DTB_, 32, 32, SLOT_, 1, (const f32x4*)(ws + WS_ROT), 20, 28, 24}; run_gemm(lds, XB_, (const bf16*)(ws + WS_WINAB), MP, NABP, 1024, G, bx, E); }
              { EpiMemKV E{p.out + O_MEMK, p.out + O_MEMV, (bf16*)(ws + WS_KB), (bf16*)(ws + WS_VB), (const float*)(ws + WS_MEMSS)};
                run_gemm(lds, (const bf16*)(ws + WS_MEMB), (const bf16*)(ws + WS_WXKV), 2048, 4096, 1024, G, G - 1 - bx, E); } } PH_END
            PH_BEGIN
            for (int u = bx; u < 256; u += G) if constexpr ((MASK & 4u) != 0) conv_unit(p, u);
            PH_END
            PH_BEGIN
#pragma unroll 1
            for (int st = 0; st < 2; ++st) {
                if ((st == 0) == (((bx >> 3) & 1) != 0)) {
                for (int v = bx; v < 512; v += G) if constexpr ((MASK & 16u) != 0) retS_unit(p, lds, v >> 2, v & 3);
                for (int v = bx; v < 512; v += G) if constexpr ((MASK & 32u) != 0) ssdS_unit(p, lds, v >> 2, v & 3);
                } else {
                for (int u = bx; u < 256; u += G) if constexpr ((MASK & 4u) != 0) { const int bg = (u & 7) * 4 + (u >> 6), hh = (u >> 3) & 7; ssdA_unit(p, lds, bg >> 2, (bg & 3) * 8 + hh); }
                for (int v = bx; v < 256; v += G) if constexpr ((MASK & 8u) != 0) { const int bh = (v & 7) * 4 + (v >> 6); retF_unit(p, lds, bh >> 2, bh & 3, (v >> 3) & 7); }
                }
            }
            PH_END
            PH_BEGIN
            for (int u = bx; u < 512; u += G) if constexpr ((MASK & 64u) != 0) ssdB_unit(p, lds, u >> 6, (u >> 4) & 3, u & 15);
            for (int v = bx; v < 256; v += G) if constexpr ((MASK & 128u) != 0) retN_unit(p, v);
            PH_END
            PH_BEGIN if constexpr ((MASK & 65536u) != 0) { EpiResid E{nullptr, XB_, SLOT_, 1.0f}; run_gemm(lds, R3_, (const bf16*)(ws + WS_WOUTAB), NP, 1024, 4096, G, bx, E);
                if constexpr ((MASK & 0x8000000u) != 0) if (bx < 128) { ThinResid T{nullptr, XB_, SLOT_, 1.0f}; thin_gemm(lds, R3_, (const bf16*)(ws + WS_WOUTAB), 4096, bx, T); } } PH_END
        } else {
            PH_BEGIN if constexpr ((MASK & 2u) != 0) {
                { EpiScale E{PB_, NC, 12, DTB_, 8, 8, SLOT_, 0, nullptr, 0, 0, 1 << 30}; run_gemm(lds, XB_, (const bf16*)(ws + WS_WINC), NP, NC, 1024, G, bx, E); }
                if constexpr ((MASK & 0x8000000u) != 0) {
                    for (int t = bx; t < 384; t += G) { ThinScaleLd T{PB_, NC, SLOT_}; thin_gemm_rc(lds, XB_, (const bf16*)(ws + WS_WINC), 1024, NP + 16 * (t & 7), 64 * (t >> 3), 0, T); }
                    for (int t = G - 1 - bx; t < 258; t += G) { ThinGate T{DTB_, SLOT_, NC}; thin_cols16(lds, XB_, (const bf16*)(ws + WS_WINC), 1024, 64 * t, NC, T); }
                } } PH_END
            PH_BEGIN
#pragma unroll 1
            for (int st = 0; st < 2; ++st) {
                if ((st == 0) == (((bx >> 3) & 1) != 0)) {
                for (int v = bx; v < 512; v += G) if constexpr ((MASK & 512u) != 0) mlS_unit(p, lds, v >> 2, v & 3);
                } else {
                for (int u = bx; u < 256; u += G) if constexpr ((MASK & 256u) != 0) mlA_unit(p, lds, u >> 5, (u >> 3) & 3, u & 7);
                }
            }
            PH_END
            PH_BEGIN
            for (int u = bx; u < 512; u += G) if constexpr ((MASK & 1024u) != 0) mlB_unit(p, lds, u >> 6, (u >> 4) & 3, u & 15);
            PH_END
            PH_BEGIN if constexpr ((MASK & 131072u) != 0) { EpiResid E{nullptr, XB_, SLOT_, 1.0f}; run_gemm(lds, R3_, (const bf16*)(ws + WS_WOUTC), NP, 1024, 1024, G, bx, E);
                if constexpr ((MASK & 0x8000000u) != 0) if (bx < 128) { ThinResid T{nullptr, XB_, SLOT_, 1.0f}; thin_gemm(lds, R3_, (const bf16*)(ws + WS_WOUTC), 1024, bx, T); } } PH_END
        }
        PH_BEGIN if constexpr ((MASK & 262144u) != 0) { EpiScale E{R3_, 1024, 4, nullptr, 0, 0, SLOT_, 0, nullptr, 0, 0, 1 << 30}; run_gemm(lds, XB_, (const bf16*)(ws + WS_WXQ + layer * SZ_SQ), NP, 1024, 1024, G, bx, E);
            if constexpr ((MASK & 0x8000000u) != 0) if (bx < 128) { ThinScale T{R3_, SLOT_}; thin_gemm(lds, XB_, (const bf16*)(ws + WS_WXQ + layer * SZ_SQ), 1024, bx, T); } } PH_END
        PH_BEGIN
#pragma unroll 1
        for (int st = 0; st < 2; ++st) {
            if ((st == 0) == (((bx >> 3) & 1) != 0)) {
            for (int v = bx; v < 256; v += G) if constexpr ((MASK & 4096u) != 0) xaS2_unit(p, lds, layer, v >> 1, v & 1);
            } else {
            for (int u = bx; u < 512; u += G) if constexpr ((MASK & 2048u) != 0) { const int idx = u >> 3, bh = (u & 7) * 4 + (idx >> 4); xaP_unit(p, lds, layer, bh >> 2, bh & 3, idx & 15); }
            }
        }
        PH_END
        PH_BEGIN if constexpr ((MASK & 524288u) != 0) { EpiResid E{nullptr, XB_, SLOT_, 1.0f}; run_gemm(lds, OB_, (const bf16*)(ws + WS_WXO + layer * SZ_SQ), NP, 1024, 1024, G, bx, E);
            if constexpr ((MASK & 0x8000000u) != 0) if (bx < 128) { ThinResid T{nullptr, XB_, SLOT_, 1.0f}; thin_gemm(lds, OB_, (const bf16*)(ws + WS_WXO + layer * SZ_SQ), 1024, bx, T); } } PH_END
        PH_BEGIN { EpiSwiglu E{R3_, SLOT_, (MASK & 0x10000000u) ? 0 : 1}; if constexpr ((MASK & 2u) != 0) run_gemm(lds, XB_, (const bf16*)(ws + WS_W2IN + layer * SZ_WIN), MP, 5632, 1024, G, bx, E); }
            if constexpr ((MASK & 0x1000001u) == 0x1000001u) { const int nact = 1430 - (1430 / G) * G; if (nact > 0 && bx >= nact) { __syncthreads(); if (layer == 0) convert_set<2>(p, lds, bx - nact, G - nact); else convert_set<4>(p, lds, bx - nact, G - nact); } } PH_END
        PH_BEGIN if constexpr ((MASK & 1048576u) != 0) { EpiResid E{nullptr, XB_, SLOT_, 0.5f}; run_gemm(lds, R3_, (const bf16*)(ws + WS_W2OUT + layer * SZ_WOUT), NP, 1024, FF, G, bx, E);
            if constexpr ((MASK & 0x8000000u) != 0) if (bx < 128) { ThinResid T{nullptr, XB_, SLOT_, 0.5f}; thin_gemm(lds, R3_, (const bf16*)(ws + WS_W2OUT + layer * SZ_WOUT), FF, bx, T); } } PH_END
    }
    PH_BEGIN
        const int vcu = (G % 8 == 0) ? (bx % 8) * (G / 8) + bx / 8 : bx;
        if constexpr ((MASK & 8192u) != 0) final_norm(p, vcu, G);
    PH_END_NOBAR
}

template <unsigned MASK>
static void launch_mega(void* const* d_in, void* d_out, void* d_ws, size_t ws_size, hipStream_t stream) {
    static int g_grid = 0;
    if (g_grid == 0) {
        int dev = 0, cus = 0;
        if (ws_size < WS_END || hipGetDevice(&dev) != hipSuccess || hipDeviceGetAttribute(&cus, hipDeviceAttributeMultiprocessorCount, dev) != hipSuccess ||
            hipFuncSetAttribute((const void*)mega_fwd<MASK>, hipFuncAttributeMaxDynamicSharedMemorySize, LDS_BYTES) != hipSuccess) {
            fprintf(stderr, "kernel_launch: setup failed (ws %zu, need %zu)\n", ws_size, (size_t)WS_END); g_grid = -1; return; }
        int per_cu = 0;
        if (hipOccupancyMaxActiveBlocksPerMultiprocessor(&per_cu, (const void*)mega_fwd<MASK>, 512, LDS_BYTES) != hipSuccess || per_cu < 1) fprintf(stderr, "kernel_launch: occupancy query says %d\n", per_cu);
        (void)hipGetLastError();
        g_grid = cus;
    }
    if (g_grid < 0) return;
    (void)hipMemsetAsync((char*)d_ws + WS_CTL, 0, 16384, stream);
    Params p{};
    for (int i = 0; i < 37; ++i) p.in[i] = (const float*)d_in[i];
    p.out = (float*)d_out; p.ws = (unsigned char*)d_ws;
    hipLaunchKernelGGL(mega_fwd<MASK>, dim3(g_grid), dim3(512), LDS_BYTES, stream, p);
}
}
extern "C" void kernel_launch(void* const* d_in, const int* in_sizes, int n_in, void* d_out, int out_size, void* d_ws, size_t ws_size, hipStream_t stream) {
    mk::launch_mega<0x1fffffffu>(d_in, d_out, d_ws, ws_size, stream);
}
```

```cpp
#include <hip/hip_runtime.h>
#include <cstdio>
#include <cstdint>
namespace pg8 {
#define PG8_LAS __attribute__((address_space(3)))
typedef unsigned short bf16_t;
typedef short bf16x8 __attribute__((ext_vector_type(8)));
typedef float f32x4 __attribute__((ext_vector_type(4)));
typedef unsigned u32x4 __attribute__((ext_vector_type(4)));
constexpr int BM = 256, BK = 64, HALF = 128, HTB = HALF * BK * 2  , STAGE_BYTES = 8 * HTB, NXCD = 8, WGM = 8;

__host__ __device__ __forceinline__ int lds_byte(int r, int c) { const int st = (r >> 4) * 2 + (c >> 5), rr = r & 15, cc = c & 31, ob = rr * 64 + cc * 2; return st * 1024 + (ob ^ (((ob >> 9) & 1) << 5)); }
__host__ __device__ __forceinline__ void stage_rc(int b, int& R, int& C) { const int st = b / 1024, sb = b % 1024, swz = sb ^ (((sb >> 9) & 1) << 5); R = (st >> 1) * 16 + swz / 64; C = (st & 1) * 32 + (swz % 64) / 2; }
__host__ __device__ __forceinline__ int perm32(int rho) { const int n = rho >> 4, i = rho & 15; return 8 * (i >> 2) + 4 * n + (i & 3); }

struct Unit { int pm, pn; };
struct Gemm { const bf16_t* A; const bf16_t* Bt; int M, N, K; };

struct StaticOrder {
    int nM, nN, nwg, G, c;
    __host__ __device__ void init(int M, int N, int G_, int c_) { nM = M / BM; nN = N / BM; nwg = nM * nN; G = G_; c = c_; }
    __host__ __device__ bool next(int i, Unit& u) const {
        const long L = (long)i * G + c; if (L >= nwg) return false;
        int wgid = (int)L; { const int q = nwg / NXCD, r = nwg % NXCD, xcd = wgid % NXCD, off = wgid / NXCD; wgid = (xcd < r ? xcd * (q + 1) : r * (q + 1) + (xcd - r) * q) + off; }
        const int nig = WGM * nN, gid = wgid / nig, fm = gid * WGM, gsz = (nM - fm) < WGM ? (nM - fm) : WGM;
        u.pm = fm + ((wgid % nig) % gsz); u.pn = (wgid % nig) / gsz; return true;
    }
    __device__ __forceinline__ void a_ready(const Unit&) const {}
    __device__ __forceinline__ void done(const Unit&) const {}
};
__device__ __forceinline__ unsigned cvt_pk_bf16(float lo, float hi) { unsigned r; asm volatile("v_cvt_pk_bf16_f32 %0, %1, %2" : "=v"(r) : "v"(lo), "v"(hi)); return r; }
template <class Epi, class Sched, bool ALIGN_EPI = false, bool SP2 = false>
__device__ __forceinline__ void gemm_phase(PG8_LAS unsigned char* lds, const Gemm g, const Sched& S, const Epi& E) {
    int tid = threadIdx.x; asm volatile("" : "+v"(tid));
    const int wid = __builtin_amdgcn_readfirstlane(tid >> 6), lane = tid & 63, wr = wid >> 2, wc = wid & 3, fr = lane & 15, fq = lane >> 4;
    const int K = g.K, nt = K / BK;
    unsigned voffA[2], voffB[2];
#pragma unroll
    for (int i = 0; i < 2; ++i) { int R, C; stage_rc(tid * 16 + i * 8192, R, C); const int Rb = Epi::PERM ? ((R & ~31) + perm32(R & 31)) : R;
        voffA[i] = (unsigned)(R * K + C) * 2u; voffB[i] = (unsigned)(Rb * K + C) * 2u; }
    const size_t kstep = (size_t)(BK * 2);
    const size_t hstep = (size_t)HALF * K * 2;
    const size_t tstep = 2 * hstep;
    const unsigned ldsw = (unsigned)wid * 1024u;
    const int aoff = lds_byte(wr * 64 + fr, fq * 8), boff = lds_byte(wc * 32 + fr, fq * 8);
#define PG8_SA(b, h) (((b) * 2 + (h)) * HTB)
#define PG8_SB(b, h) ((4 + (b) * 2 + (h)) * HTB)
#define PG8_STAGE(bufoff, gbase, voff) do { _Pragma("unroll") for (int _i = 0; _i < 2; ++_i) \
        __builtin_amdgcn_global_load_lds((const unsigned*)((const char*)(gbase) + (voff)[_i]), (PG8_LAS unsigned*)(lds + (bufoff) + ldsw + _i * 8192), 16, 0, 0); } while (0)
#define PG8_LDA(dst, b, h) do { _Pragma("unroll") for (int m = 0; m < 4; ++m) _Pragma("unroll") for (int k = 0; k < 2; ++k) dst[m][k] = *(const PG8_LAS bf16x8*)(lds + PG8_SA(b, h) + aoff + m * 2048 + k * 1024); } while (0)
#define PG8_LDB(dst, b, h) do { _Pragma("unroll") for (int n = 0; n < 2; ++n) _Pragma("unroll") for (int k = 0; k < 2; ++k) dst[n][k] = *(const PG8_LAS bf16x8*)(lds + PG8_SB(b, h) + boff + n * 2048 + k * 1024); } while (0)
#define PG8_MMA(ai, bj, At, Bt) do { __builtin_amdgcn_s_setprio(1); _Pragma("unroll") for (int m = 0; m < 4; ++m) _Pragma("unroll") for (int n = 0; n < 2; ++n) _Pragma("unroll") for (int k = 0; k < 2; ++k) \
        acc[ai][bj][m][n] = __builtin_amdgcn_mfma_f32_16x16x32_bf16(Bt[n][k], At[m][k], acc[ai][bj][m][n], 0, 0, 0); __builtin_amdgcn_s_setprio(0); } while (0)
#define PG8_WAIT_V(n) asm volatile("s_waitcnt vmcnt(" #n ")" ::: "memory")
#define PG8_WAIT_L(n) asm volatile("s_waitcnt lgkmcnt(" #n ")" ::: "memory")
#define PG8_BAR __builtin_amdgcn_s_barrier()
#define PG8_SCHED __builtin_amdgcn_sched_barrier(0)
    Unit cur, nxt; int ui = 0;
    if (!S.next(0, cur)) return;
    f32x4 acc[2][2][4][2];
#pragma unroll
    for (int a = 0; a < 2; ++a)
#pragma unroll
        for (int b = 0; b < 2; ++b)
#pragma unroll
            for (int m = 0; m < 4; ++m)
#pragma unroll
                for (int n = 0; n < 2; ++n) acc[a][b][m][n] = (f32x4){0.f, 0.f, 0.f, 0.f};
    bf16x8 At[4][2], B0[2][2], B1[2][2];
    const char* cA = (const char*)g.A + (size_t)cur.pm * tstep; const char* cB = (const char*)g.Bt + (size_t)cur.pn * tstep;
    S.a_ready(cur);
    if constexpr (SP2) {
        PG8_STAGE(PG8_SB(0, 0), cB, voffB); PG8_STAGE(PG8_SB(0, 1), cB + hstep, voffB); PG8_STAGE(PG8_SA(0, 0), cA, voffA); PG8_STAGE(PG8_SA(0, 1), cA + hstep, voffA);
        if (wr == 1) PG8_BAR;
        PG8_WAIT_V(2); PG8_BAR;
        PG8_STAGE(PG8_SB(1, 0), cB + kstep, voffB); PG8_STAGE(PG8_SA(1, 0), cA + kstep, voffA); PG8_STAGE(PG8_SB(1, 1), cB + hstep + kstep, voffB);
        PG8_WAIT_V(6); PG8_BAR;
    } else {
        PG8_STAGE(PG8_SB(0, 0), cB, voffB); PG8_STAGE(PG8_SA(0, 0), cA, voffA); PG8_STAGE(PG8_SB(0, 1), cB + hstep, voffB); PG8_STAGE(PG8_SA(0, 1), cA + hstep, voffA);
        if (wr == 1) PG8_BAR;
        PG8_WAIT_V(4); PG8_BAR;
        PG8_STAGE(PG8_SB(1, 0), cB + kstep, voffB); PG8_STAGE(PG8_SA(1, 0), cA + kstep, voffA); PG8_STAGE(PG8_SB(1, 1), cB + hstep + kstep, voffB);
        PG8_WAIT_V(6); PG8_BAR;
    }
    for (;;) {
        const bool has_next = S.next(ui + 1, nxt);
        const char* nA = has_next ? (const char*)g.A + (size_t)nxt.pm * tstep : cA; const char* nB = has_next ? (const char*)g.Bt + (size_t)nxt.pn * tstep : cB;
        for (int t = 0; t < nt; t += 2) {
            const bool last = (t == nt - 2);
            const char* a1 = cA + (size_t)(t + 1) * kstep;
            const char* a2 = last ? nA : cA + (size_t)(t + 2) * kstep; const char* b2 = last ? nB : cB + (size_t)(t + 2) * kstep;
            const char* a3 = a2 + kstep; const char* b3 = b2 + kstep;
            if (last && has_next) S.a_ready(nxt);
            if constexpr (SP2) {
            PG8_LDB(B0, 0, 0); PG8_LDB(B1, 0, 1); PG8_SCHED; PG8_LDA(At, 0, 0); PG8_STAGE(PG8_SA(1, 1), a1 + hstep, voffA);
            PG8_WAIT_V(8); PG8_WAIT_L(0); PG8_BAR; PG8_MMA(0, 0, At, B0); PG8_MMA(0, 1, At, B1); PG8_BAR; PG8_SCHED;
            PG8_LDA(At, 0, 1); PG8_STAGE(PG8_SB(0, 0), b2, voffB); PG8_STAGE(PG8_SB(0, 1), b2 + hstep, voffB); PG8_STAGE(PG8_SA(0, 0), a2, voffA);
            PG8_WAIT_V(8); PG8_WAIT_L(0); PG8_BAR; PG8_MMA(1, 0, At, B0); PG8_MMA(1, 1, At, B1); PG8_BAR; PG8_SCHED;
            if constexpr (Epi::STASH) { int tz = t; asm volatile("" : "+s"(tz)); if (tz == 0) E.stash(lds, cur, wid, lane); }
            PG8_LDB(B0, 1, 0); PG8_LDB(B1, 1, 1); PG8_SCHED; PG8_LDA(At, 1, 0); PG8_STAGE(PG8_SA(0, 1), a2 + hstep, voffA);
            PG8_WAIT_V(8); PG8_WAIT_L(0); PG8_BAR; PG8_MMA(0, 0, At, B0); PG8_MMA(0, 1, At, B1); PG8_BAR; PG8_SCHED;
            PG8_LDA(At, 1, 1); PG8_STAGE(PG8_SB(1, 0), b3, voffB); PG8_STAGE(PG8_SB(1, 1), b3 + hstep, voffB); PG8_STAGE(PG8_SA(1, 0), a3, voffA);
            PG8_WAIT_V(8); PG8_WAIT_L(0); PG8_BAR; PG8_MMA(1, 0, At, B0); PG8_MMA(1, 1, At, B1); PG8_BAR; PG8_SCHED;
            } else {
            PG8_LDB(B0, 0, 0); PG8_SCHED; PG8_LDA(At, 0, 0); PG8_STAGE(PG8_SA(1, 1), a1 + hstep, voffA);
            PG8_WAIT_L(8); PG8_BAR; PG8_WAIT_L(0); PG8_MMA(0, 0, At, B0); PG8_BAR; PG8_SCHED;
            PG8_LDB(B1, 0, 1); PG8_STAGE(PG8_SB(0, 0), b2, voffB);
            PG8_BAR; PG8_WAIT_L(0); PG8_MMA(0, 1, At, B1); PG8_BAR;
            PG8_LDA(At, 0, 1); PG8_STAGE(PG8_SA(0, 0), a2, voffA);
            PG8_BAR; PG8_WAIT_L(0); PG8_MMA(1, 0, At, B0); PG8_BAR; PG8_SCHED;
            PG8_STAGE(PG8_SB(0, 1), b2 + hstep, voffB);
            PG8_WAIT_V(6); PG8_BAR; PG8_MMA(1, 1, At, B1); PG8_BAR;
            PG8_LDB(B0, 1, 0); PG8_SCHED; PG8_LDA(At, 1, 0); PG8_STAGE(PG8_SA(0, 1), a2 + hstep, voffA);
            PG8_WAIT_L(8); PG8_BAR; PG8_WAIT_L(0); PG8_MMA(0, 0, At, B0); PG8_BAR; PG8_SCHED;
            PG8_LDB(B1, 1, 1); PG8_STAGE(PG8_SB(1, 0), b3, voffB);
            PG8_BAR; PG8_WAIT_L(0); PG8_MMA(0, 1, At, B1); PG8_BAR;
            PG8_LDA(At, 1, 1); PG8_STAGE(PG8_SA(1, 0), a3, voffA);
            PG8_BAR; PG8_WAIT_L(0); PG8_MMA(1, 0, At, B0); PG8_BAR; PG8_SCHED;
            PG8_STAGE(PG8_SB(1, 1), b3 + hstep, voffB);
            PG8_WAIT_V(6); PG8_BAR; PG8_MMA(1, 1, At, B1); PG8_BAR;
            }
        }
        if constexpr (ALIGN_EPI) { if (wr == 0) PG8_BAR; }
        if constexpr (!Epi::AFTER_DRAIN) { E(acc, cur, wr, wc, fr, fq, lds); S.done(cur); }
        if (!has_next) break;
#pragma unroll
        for (int a = 0; a < 2; ++a)
#pragma unroll
            for (int b = 0; b < 2; ++b)
#pragma unroll
                for (int m = 0; m < 4; ++m)
#pragma unroll
                    for (int n = 0; n < 2; ++n) acc[a][b][m][n] = (f32x4){0.f, 0.f, 0.f, 0.f};
        cur = nxt; cA = nA; cB = nB; ++ui;
        if constexpr (ALIGN_EPI) { if (wr == 1) PG8_BAR; }
    }
    PG8_WAIT_V(0);
    if constexpr (!ALIGN_EPI) { if (wr == 0) PG8_BAR; }
    PG8_BAR;
    if constexpr (Epi::AFTER_DRAIN) { E.fused(acc, cur, wr, wc, fr, fq, lds, wid, lane); S.done(cur); }
#undef PG8_SA
#undef PG8_SB
#undef PG8_STAGE
#undef PG8_LDA
#undef PG8_LDB
#undef PG8_MMA
#undef PG8_WAIT_V
#undef PG8_WAIT_L
#undef PG8_BAR
#undef PG8_SCHED
}
}

#define LAS __attribute__((address_space(3)))
#define XB_TMO      128
#define XB_XCNT(j)  (256  + 64 * (j))
#define XB_XSUB(j)  (1280 + 64 * (j))
#define XB_XGEN(j)  (2304 + 64 * (j))
#define XB_TOP      3328
#define XB_TOPGEN   3392
#define XCD_BAR_WORDS 3456
#define XB_SPIN_CAP (1u << 18)

__device__ __forceinline__ unsigned xb_ld(unsigned* p)              { return __hip_atomic_load(p, __ATOMIC_RELAXED, __HIP_MEMORY_SCOPE_AGENT); }
__device__ __forceinline__ unsigned xb_add(unsigned* p, unsigned v) { return __hip_atomic_fetch_add(p, v, __ATOMIC_RELAXED, __HIP_MEMORY_SCOPE_AGENT); }
__device__ __forceinline__ unsigned xb_xcc_id() { return (unsigned)__builtin_amdgcn_s_getreg((3 << 11) | 20) & 0xFu; }
#define XB_SPIN(cond, bar) do { unsigned _sp = 0; while (cond) { __builtin_amdgcn_s_sleep(1); \
    if ((++_sp & 255u) == 0u) { if (xb_ld(&(bar)[XB_TMO])) break; if (_sp > XB_SPIN_CAP) { atomicAdd(&(bar)[XB_TMO], 1u); break; } } } } while (0)

struct XcdBarrier {
    unsigned* bar; unsigned x;
    volatile LAS unsigned* st;
};

__device__ __forceinline__ XcdBarrier xcd_barrier_post(unsigned* bar, volatile LAS unsigned* st) {
    XcdBarrier b; b.bar = bar; b.x = xb_xcc_id(); b.st = st;
    if (threadIdx.x == 0) (void)xb_add(&bar[XB_XCNT(b.x)], 1u);
    return b;
}
__device__ __forceinline__ void xcd_barrier_complete(unsigned* bar, unsigned x, unsigned& nloc, unsigned& nx) {
    const unsigned G = gridDim.x * gridDim.y * gridDim.z;
    unsigned sum, cnt, mine, sp = 0u;
    for (;;) {
        sum = 0u; cnt = 0u; mine = 0u;
#pragma unroll
        for (unsigned j = 0; j < 16; ++j) { const unsigned c = xb_ld(&bar[XB_XCNT(j)]); sum += c; cnt += (c > 0u) ? 1u : 0u; mine = (j == x) ? c : mine; }
        if (sum == G) break;
        __builtin_amdgcn_s_sleep(1);
        if ((++sp & 255u) == 0u) { if (xb_ld(&bar[XB_TMO])) break; if (sp > XB_SPIN_CAP) { atomicAdd(&bar[XB_TMO], 1u); break; } }
    }
    nloc = mine > 0u ? mine : 1u; nx = cnt > 0u ? cnt : 1u;
}

__device__ __forceinline__ void xcd_barrier(const XcdBarrier& b) {
    asm volatile("s_waitcnt vmcnt(0)" ::: "memory");
    __syncthreads();
    if (threadIdx.x == 0) {
        unsigned* bar = b.bar;
        __builtin_amdgcn_s_waitcnt(0);
        unsigned nloc = b.st[0], nx = b.st[1];
        if (nloc == 0u) { xcd_barrier_complete(bar, b.x, nloc, nx); b.st[0] = nloc; b.st[1] = nx; }
        const unsigned old = xb_add(&bar[XB_XSUB(b.x)], 1u);
        const unsigned gen = old / nloc;
        if (old + 1u == (gen + 1u) * nloc) {
            __builtin_amdgcn_fence(__ATOMIC_RELEASE, "agent");
            asm volatile("s_waitcnt vmcnt(0)" ::: "memory");
            const unsigned og = xb_add(&bar[XB_TOP], 1u);
            const unsigned tg = og / nx;
            if (og + 1u == (tg + 1u) * nx) xb_add(&bar[XB_TOPGEN], 1u);
            else XB_SPIN(xb_ld(&bar[XB_TOPGEN]) == tg, bar);
            __builtin_amdgcn_fence(__ATOMIC_ACQUIRE, "agent");
            xb_add(&bar[XB_XGEN(b.x)], 1u);
            asm volatile("s_waitcnt vmcnt(0)" ::: "memory");
        } else {
            XB_SPIN(xb_ld(&bar[XB_XGEN(b.x)]) == gen, bar);
            __builtin_amdgcn_fence(__ATOMIC_ACQUIRE, "agent");
            asm volatile("s_waitcnt vmcnt(0)" ::: "memory");
        }
    }
    __syncthreads();
}
namespace mk {
#define GAS __attribute__((address_space(1)))
typedef unsigned short bf16;
typedef short bf16x8 __attribute__((ext_vector_type(8)));
typedef short s16x4 __attribute__((ext_vector_type(4)));
typedef float f32x4 __attribute__((ext_vector_type(4)));
typedef float f32x2 __attribute__((ext_vector_type(2)));
typedef unsigned u32x4 __attribute__((ext_vector_type(4)));
typedef unsigned u32x2 __attribute__((ext_vector_type(2)));
typedef LAS unsigned char* ldsp;

constexpr int D = 1024, FF = 2816, NP = 16384, NS = 128, MR = 16512, MP = 16640, SEQ = 2048;
constexpr int NAB = 11264, NABP = 11520, NC = 3072, NCP = 3328;
constexpr int PZ = 0, PX = 2048, PB = 4096, PC = 4608, PRQ = 5120, PRK = 6144, PRV = 7168, PRG = 9216;
constexpr int CQ = 0, CK = 512, CV = 1024, CO = 2048;
constexpr size_t O_Y = 0, O_MEMK = 16908288, O_MEMV = 21102592, O_CONVP = 25296896, O_CONVS = 25370624, O_SSMP = 26550272, O_SSMS = 28647424,
                 O_RETP = 62201856, O_RETS = 66396160, O_MCP = 133505024, O_MCS = 134553600, O_MNP = 151330816, O_MNS = 151334912, O_MMP = 151400448, O_MMS = 151400480;

constexpr size_t al256(size_t x) { return (x + 255) & ~(size_t)255; }
constexpr size_t WS_CTL = 0, CTL_BYTES = 1u << 20;
constexpr size_t WS_ROT = CTL_BYTES;
constexpr size_t WS_W1IN = WS_ROT + al256((size_t)2049 * 128 * 8);
constexpr size_t SZ_WIN = (size_t)5632 * 1024 * 2, SZ_WOUT = (size_t)1024 * 2816 * 2, SZ_SQ = (size_t)1024 * 1024 * 2;
constexpr size_t WS_W2IN = WS_W1IN + 2 * SZ_WIN;
constexpr size_t WS_W1OUT = WS_W2IN + 2 * SZ_WIN;
constexpr size_t WS_W2OUT = WS_W1OUT + 2 * SZ_WOUT;
constexpr size_t WS_WINAB = WS_W2OUT + 2 * SZ_WOUT;
constexpr size_t WS_WOUTAB = WS_WINAB + (size_t)NABP * 1024 * 2;
constexpr size_t WS_WINC = WS_WOUTAB + (size_t)1024 * 4096 * 2;
constexpr size_t WS_WOUTC = WS_WINC + (size_t)NCP * 1024 * 2;
constexpr size_t WS_WXQ = WS_WOUTC + SZ_SQ;
constexpr size_t WS_WXO = WS_WXQ + 2 * SZ_SQ;
constexpr size_t WS_WXKV = WS_WXO + 2 * SZ_SQ;
constexpr size_t WS_X = WS_WXKV + (size_t)4096 * 1024 * 2;
constexpr size_t WS_XB = WS_X + (size_t)MP * 1024 * 4;
constexpr size_t WS_SLOT = WS_XB + (size_t)MP * 1024 * 2;
constexpr size_t WS_MEMB = WS_SLOT + (size_t)MP * 16 * 4;
constexpr size_t WS_MEMSS = WS_MEMB + (size_t)2048 * 1024 * 2;
constexpr size_t WS_KB = WS_MEMSS + 8192;
constexpr size_t WS_VB = WS_KB + (size_t)2 * 2048 * 1024 * 2;
constexpr size_t WS_R3 = WS_VB + (size_t)2 * 2048 * 1024 * 2;
constexpr size_t SZ_R3 = (size_t)MP * 4096 * 2;
constexpr size_t WS_P = WS_R3 + SZ_R3;
constexpr size_t WS_DT = WS_P + (size_t)MP * NAB * 2;
constexpr size_t WS_HC = WS_DT + (size_t)MP * 32 * 4;
constexpr size_t WS_SC = WS_HC + (size_t)8 * 32 * 16 * 64 * 128 * 2;
constexpr size_t WS_MCH = WS_SC + (size_t)8 * 4 * 16 * 512 * 256 * 2;
constexpr size_t WS_XC = WS_MCH + 4096;
constexpr size_t WS_RSS = WS_XC + (size_t)MP * 3072 * 2;
constexpr size_t WS_SSS = WS_RSS + (size_t)NP * 32 * 4;
constexpr size_t WS_END = WS_SSS + (size_t)NP * 32 * 4;

struct Params { const float* in[37]; float* out; unsigned char* ws; };
constexpr int LDSCTL_OFF = 139264;
constexpr int LDS_INTAB = LDSCTL_OFF + 256;
struct Ctx { ldsp lds; unsigned char* ws; float* out;
    __device__ __forceinline__ const float* in(int i) const {
        unsigned z; asm volatile("s_mov_b32 %0, 0" : "=s"(z));
        const unsigned addr = z + (unsigned)(size_t)(lds + LDS_INTAB) + 8u * (unsigned)i;
        const unsigned long long v = *(const LAS unsigned long long*)(size_t)addr;
        return (const float*)(((unsigned long long)(unsigned)__builtin_amdgcn_readfirstlane((int)(unsigned)(v >> 32)) << 32) | (unsigned long long)(unsigned)__builtin_amdgcn_readfirstlane((int)(unsigned)v));
    } };

__device__ __forceinline__ int opaque_tid() { int t = threadIdx.x; asm volatile("" : "+v"(t)); return t; }
__device__ __forceinline__ float bf2f(unsigned short b) { return __uint_as_float((unsigned)b << 16); }
__device__ __forceinline__ float bflo(unsigned w) { return __uint_as_float(w << 16); }
__device__ __forceinline__ float bfhi(unsigned w) { return __uint_as_float(w & 0xffff0000u); }
__device__ __forceinline__ unsigned pk2(float lo, float hi) { unsigned r; asm("v_cvt_pk_bf16_f32 %0, %1, %2" : "=v"(r) : "v"(lo), "v"(hi)); return r; }
__device__ __forceinline__ float siluf(float x) { return x * __builtin_amdgcn_rcpf(1.f + __expf(-x)); }
__device__ __forceinline__ float sigmf(float x) { return __builtin_amdgcn_rcpf(1.f + __expf(-x)); }
__device__ __forceinline__ float softplusf(float v) { return v > 20.f ? v : log1pf(expf(v)); }
__device__ __forceinline__ float logsigf(float x) { return fminf(x, 0.f) - log1pf(expf(-fabsf(x))); }
__device__ __forceinline__ float wave_sum(float v) {
#pragma unroll
    for (int o = 1; o < 64; o <<= 1) v += __shfl_xor(v, o);
    return v;
}
__device__ __forceinline__ float wave_max(float v) {
#pragma unroll
    for (int o = 1; o < 64; o <<= 1) v = fmaxf(v, __shfl_xor(v, o));
    return v;
}
#define LDSW() asm volatile("s_waitcnt lgkmcnt(0)" ::: "memory")
__device__ __forceinline__ void unpack8(const u32x4 w, float (&v)[8]) {
    v[0] = bflo(w.x); v[1] = bfhi(w.x); v[2] = bflo(w.y); v[3] = bfhi(w.y); v[4] = bflo(w.z); v[5] = bfhi(w.z); v[6] = bflo(w.w); v[7] = bfhi(w.w);
}
__device__ __forceinline__ u32x4 pack8(const float (&v)[8]) { u32x4 w; w.x = pk2(v[0], v[1]); w.y = pk2(v[2], v[3]); w.z = pk2(v[4], v[5]); w.w = pk2(v[6], v[7]); return w; }

__device__ __forceinline__ f32x4 ldnt4(const float* p) { return *(const f32x4*)p; }
__device__ __forceinline__ void stnt4(float* p, f32x4 v) { *(f32x4*)p = v; }

typedef short v4i16_t __attribute__((ext_vector_type(4)));
__device__ __forceinline__ s16x4 tr4(ldsp p) { return __builtin_bit_cast(s16x4, __builtin_amdgcn_ds_read_tr16_b64_v4i16((LAS v4i16_t*)p)); }
__device__ __forceinline__ bf16x8 cat8(s16x4 a, s16x4 b) { bf16x8 r; r[0] = a[0]; r[1] = a[1]; r[2] = a[2]; r[3] = a[3]; r[4] = b[0]; r[5] = b[1]; r[6] = b[2]; r[7] = b[3]; return r; }
__device__ __forceinline__ bf16x8 trfrag(ldsp img, int rs, int k0, int c0, int lane) {
    const int g = lane >> 4, i = lane & 15, q = i >> 2, pp = i & 3;
    ldsp a = img + (k0 + 8 * g + q) * rs + (c0 + 4 * pp) * 2;
    return cat8(tr4(a), tr4(a + 4 * rs));
}
__device__ __forceinline__ bf16x8 trfragp(ldsp img, int rs, int k0, int c0, int lane) {
    const int g = lane >> 4, i = lane & 15, q = i >> 2, pp = i & 3;
    ldsp a = img + (k0 + 4 * g + q) * rs + (c0 + 4 * pp) * 2;
    return cat8(tr4(a), tr4(a + 16 * rs));
}
__device__ __forceinline__ bf16x8 rowfrag(ldsp img, int rs, int r0, int k0, int lane) {
    return *(const LAS bf16x8*)(img + (r0 + (lane & 15)) * rs + (k0 + 8 * (lane >> 4)) * 2);
}
__device__ __forceinline__ bf16x8 gfrag(const bf16* base, size_t ld, int r0, int k0, int lane) {
    return *(const bf16x8*)(base + (size_t)(r0 + (lane & 15)) * ld + k0 + 8 * (lane >> 4));
}
__device__ __forceinline__ f32x4 mfma16(bf16x8 a, bf16x8 b, f32x4 c) { return __builtin_amdgcn_mfma_f32_16x16x32_bf16(a, b, c, 0, 0, 0); }
__device__ __forceinline__ bf16x8 packP(f32x4 a, f32x4 b) {
    u32x4 w; w.x = pk2(a[0], a[1]); w.y = pk2(a[2], a[3]); w.z = pk2(b[0], b[1]); w.w = pk2(b[2], b[3]); return __builtin_bit_cast(bf16x8, w);
}

__device__ __forceinline__ float rstd_of(const float* slot, int row) {
    const f32x4* s = (const f32x4*)(slot + (size_t)row * 16);
    const f32x4 a = (s[0] + s[1]) + (s[2] + s[3]);
    return rsqrtf(((a.x + a.y) + (a.z + a.w)) * (1.0f / 1024.0f) + 1e-6f);
}
__device__ __forceinline__ void rstd8(const float* slot, int row0, int fq, float (&rs)[2][4]) {
    f32x4 q[2][4];
#pragma unroll
    for (int ai = 0; ai < 2; ++ai)
#pragma unroll
        for (int m = 0; m < 4; ++m) q[ai][m] = *(const f32x4*)(slot + (size_t)(row0 + ai * 128 + m * 16) * 16 + 4 * fq);
#pragma unroll
    for (int ai = 0; ai < 2; ++ai)
#pragma unroll
        for (int m = 0; m < 4; ++m) { float s = (q[ai][m].x + q[ai][m].y) + (q[ai][m].z + q[ai][m].w); s += __shfl_xor(s, 16); s += __shfl_xor(s, 32); rs[ai][m] = rsqrtf(s * (1.0f / 1024.0f) + 1e-6f); }
}
constexpr int STASH0 = 131072, STASH1 = 140288;
__device__ __forceinline__ void slot_stash(ldsp lds, const float* slot, int pm, int wid, int) {
    unsigned lane = __builtin_amdgcn_mbcnt_hi(~0u, __builtin_amdgcn_mbcnt_lo(~0u, 0u)); asm volatile("" : "+v"(lane));
    const char* sp = (const char*)(slot + (size_t)pm * 256 * 16) + wid * 2048;
    const int base = wid < 4 ? STASH0 + wid * 2048 : STASH1 + (wid - 4) * 2048;
    __builtin_amdgcn_global_load_lds((const unsigned*)(sp + lane * 16u), (LAS unsigned*)(lds + base), 16, 0, 0);
    __builtin_amdgcn_global_load_lds((const unsigned*)(sp + 1024 + lane * 16u), (LAS unsigned*)(lds + base + 1024), 16, 0, 0);
}
__device__ __forceinline__ void rstd8_lds(ldsp lds, int wr, int fr, int fq, float (&rs)[2][4]) {
    unsigned off = (unsigned)(wr * 4096 + fr * 64 + fq * 16); asm volatile("" : "+v"(off));
    const LAS unsigned char* b = lds + STASH0 + off;
#pragma unroll
    for (int ai = 0; ai < 2; ++ai)
#pragma unroll
        for (int m = 0; m < 4; ++m) {
            const f32x4 q = *(const LAS f32x4*)(b + ai * (STASH1 - STASH0) + m * 1024);
            float s = (q.x + q.y) + (q.z + q.w); s += __shfl_xor(s, 16); s += __shfl_xor(s, 32); rs[ai][m] = rsqrtf(s * (1.0f / 1024.0f) + 1e-6f);
        }
}
typedef float v2f __attribute__((ext_vector_type(2)));
struct EpiSwiglu {
    static constexpr bool PERM = true, AFTER_DRAIN = false;
    bf16* H; const float* slot; int skip;
    static constexpr bool STASH = true;
    __device__ __forceinline__ void stash(ldsp lds, const pg8::Unit& u, int wid, int lane) const { slot_stash(lds, slot, u.pm, wid, lane); }
    __device__ __forceinline__ void operator()(const pg8::f32x4 (&acc)[2][2][4][2], const pg8::Unit& u, int wr, int wc, int fr, int fq, ldsp lds) const {
        if (skip) {
            float s = 0.f;
#pragma unroll
            for (int ai = 0; ai < 2; ++ai)
#pragma unroll
                for (int bj = 0; bj < 2; ++bj)
#pragma unroll
                    for (int m = 0; m < 4; ++m)
#pragma unroll
                        for (int n = 0; n < 2; ++n) s += (acc[ai][bj][m][n][0] + acc[ai][bj][m][n][1]) + (acc[ai][bj][m][n][2] + acc[ai][bj][m][n][3]);
            if (s == 123.456f) H[0] = 1;
            return;
        }
        const int row0 = u.pm * 256 + wr * 64 + fr;
        float rs[2][4]; rstd8_lds(lds, wr, fr, fq, rs);
#pragma unroll
        for (int ai = 0; ai < 2; ++ai)
#pragma unroll
            for (int m = 0; m < 4; ++m) {
                const int row = row0 + ai * 128 + m * 16; const float r = rs[ai][m];
                const float rl = r * -1.44269504089f, ir2 = __builtin_amdgcn_rcpf(r * r);
                float o[8];
#pragma unroll
                for (int n = 0; n < 2; ++n)
#pragma unroll
                    for (int h = 0; h < 2; ++h) {
                        const v2f g2 = {acc[ai][0][m][n][2 * h], acc[ai][0][m][n][2 * h + 1]}, u2 = {acc[ai][1][m][n][2 * h], acc[ai][1][m][n][2 * h + 1]};
                        const v2f t = g2 * rl, pr = g2 * u2;
                        v2f ex; ex.x = __builtin_amdgcn_exp2f(t.x); ex.y = __builtin_amdgcn_exp2f(t.y);
                        const v2f dn = ex * ir2 + ir2;
                        v2f q; q.x = __builtin_amdgcn_rcpf(dn.x); q.y = __builtin_amdgcn_rcpf(dn.y);
                        const v2f w = pr * q;
                        o[n * 4 + 2 * h] = w.x; o[n * 4 + 2 * h + 1] = w.y;
                    }
                *(u32x4*)(H + (size_t)row * FF + u.pn * 128 + wc * 32 + fq * 8) = pack8(o);
            }
    }
};
struct EpiResid {
    static constexpr bool PERM = true, AFTER_DRAIN = false;
    const float* Xin32; bf16* XB; float* slot; float scale;
    static constexpr bool STASH = false;
    __device__ __forceinline__ void operator()(const pg8::f32x4 (&acc)[2][2][4][2], const pg8::Unit& u, int wr, int wc, int fr, int fq, ldsp) const {
        const int row0 = u.pm * 256 + wr * 64 + fr, col0 = u.pn * 256 + wc * 32 + fq * 8;
#pragma unroll
        for (int ai = 0; ai < 2; ++ai) {
            u32x4 raw[4][2];
            if (Xin32 == nullptr) {
#pragma unroll
                for (int m = 0; m < 4; ++m)
#pragma unroll
                    for (int bj = 0; bj < 2; ++bj) raw[m][bj] = *(const u32x4*)(XB + (size_t)(row0 + ai * 128 + m * 16) * D + col0 + bj * 128);
            }
#pragma unroll
            for (int m = 0; m < 4; ++m) {
                const int row = row0 + ai * 128 + m * 16; float ss = 0.f;
#pragma unroll
                for (int bj = 0; bj < 2; ++bj) {
                    float x[8];
                    if (Xin32 != nullptr) { const float* xi = Xin32 + (size_t)row * D + col0 + bj * 128; const f32x4 a0 = *(const f32x4*)xi, a1 = *(const f32x4*)(xi + 4);
                        x[0] = a0.x; x[1] = a0.y; x[2] = a0.z; x[3] = a0.w; x[4] = a1.x; x[5] = a1.y; x[6] = a1.z; x[7] = a1.w; }
                    else unpack8(raw[m][bj], x);
#pragma unroll
                    for (int e = 0; e < 4; ++e) { x[e] += scale * acc[ai][bj][m][0][e]; x[4 + e] += scale * acc[ai][bj][m][1][e]; }
                    const u32x4 w = pack8(x);
                    *(u32x4*)(XB + (size_t)row * D + col0 + bj * 128) = w;
                    float y[8]; unpack8(w, y);
#pragma unroll
                    for (int e = 0; e < 8; ++e) ss += y[e] * y[e];
                }
                ss += __shfl_xor(ss, 16); ss += __shfl_xor(ss, 32);
                if (fq == 0) slot[(size_t)row * 16 + u.pn * 4 + wc] = ss;
            }
        }
    }
};
template <bool ST> struct EpiScaleT {
    static constexpr bool PERM = true, AFTER_DRAIN = false;
    bf16* O; int ldo; int nmain; float* side; int side_ld; int side_n; const float* slot; int nt;
    const f32x4* rot; int rot_lo, rot_hi, rot_k;
    static constexpr bool STASH = ST;
    __device__ __forceinline__ void stash(ldsp lds, const pg8::Unit& u, int wid, int lane) const { slot_stash(lds, slot, u.pm, wid, lane); }
    __device__ __forceinline__ void operator()(const pg8::f32x4 (&acc)[2][2][4][2], const pg8::Unit& u, int wr, int wc, int fr, int fq, ldsp lds) const {
        asm volatile("" : "+v"(fr), "+v"(fq));
        const int row0 = u.pm * 256 + wr * 64 + fr;
        const bool dorot = rot != nullptr && u.pn >= rot_lo && u.pn < rot_hi;
        const float ksc = u.pn >= rot_k ? 0.0625f : 1.0f;
        float rsa[2][4]; if constexpr (ST) rstd8_lds(lds, wr, fr, fq, rsa); else rstd8(slot, row0, fq, rsa);
#pragma unroll
        for (int ai = 0; ai < 2; ++ai)
#pragma unroll
            for (int mp = 0; mp < 4; mp += 2) {
                const float rs[2] = {rsa[ai][mp], rsa[ai][mp + 1]};
                f32x4 rt[2][2][2];
                if (dorot) {
#pragma unroll
                    for (int mm = 0; mm < 2; ++mm) {
                        const int row = row0 + ai * 128 + (mp + mm) * 16; const int pos = row < NP ? (row & (SEQ - 1)) : 2048;
#pragma unroll
                        for (int n = 0; n < 2; ++n) { const f32x4* rp = rot + ((size_t)pos * 128 + wc * 32 + fq * 8 + n * 4) / 2; rt[mm][n][0] = rp[0]; rt[mm][n][1] = rp[1]; }
                    }
                }
#pragma unroll
                for (int mm = 0; mm < 2; ++mm) {
                    const int m = mp + mm, row = row0 + ai * 128 + m * 16; const float r = rs[mm];
                    if (u.pn < nmain) {
                        f32x4 v[2][2];
#pragma unroll
                        for (int bj = 0; bj < 2; ++bj)
#pragma unroll
                            for (int n = 0; n < 2; ++n) v[bj][n] = acc[ai][bj][m][n] * r;
                        if (dorot) {
#pragma unroll
                            for (int n = 0; n < 2; ++n) {
                                const f32x4 cs0 = rt[mm][n][0], cs1 = rt[mm][n][1];
                                const f32x4 c = (f32x4){cs0.x, cs0.z, cs1.x, cs1.z} * ksc, s = (f32x4){cs0.y, cs0.w, cs1.y, cs1.w} * ksc;
                                const f32x4 x1 = v[0][n], x2 = v[1][n];
                                v[0][n] = x1 * c - x2 * s; v[1][n] = x1 * s + x2 * c;
                            }
                        }
#pragma unroll
                        for (int bj = 0; bj < 2; ++bj) {
                            const f32x4 v0 = v[bj][0], v1 = v[bj][1];
                            u32x4 w; w.x = pk2(v0.x, v0.y); w.y = pk2(v0.z, v0.w); w.z = pk2(v1.x, v1.y); w.w = pk2(v1.z, v1.w);
                            u32x4* dst = (u32x4*)(O + (size_t)row * ldo + u.pn * 256 + bj * 128 + wc * 32 + fq * 8);
                            if (nt) __builtin_nontemporal_store(w, dst); else *dst = w;
                        }
                    } else if (wc == 0) {
#pragma unroll
                        for (int n = 0; n < 2; ++n)
#pragma unroll
                            for (int e = 0; e < 4; ++e) { const int c = fq * 8 + n * 4 + e; if (c < side_n) side[(size_t)row * side_ld + c] = acc[ai][0][m][n][e] * r; }
                    }
                }
            }
    }
};
using EpiScale = EpiScaleT<true>;
using EpiScaleG = EpiScaleT<false>;
struct EpiMemKV {
    static constexpr bool PERM = true, AFTER_DRAIN = false;
    float* outk; float* outv; bf16* KB; bf16* VB; const float* memss;
    static constexpr bool STASH = false;
    __device__ __forceinline__ void operator()(const pg8::f32x4 (&acc)[2][2][4][2], const pg8::Unit& u, int wr, int wc, int fr, int fq, ldsp) const {
        const int row0 = u.pm * 256 + wr * 64 + fr;
        const int layer = u.pn >> 3, isv = (u.pn >> 2) & 1, ct = u.pn & 3;
        float* of = (isv ? outv : outk) + (size_t)layer * 2048 * 1024; bf16* ob = (isv ? VB : KB) + (size_t)layer * 2048 * 1024;
#pragma unroll
        for (int ai = 0; ai < 2; ++ai)
#pragma unroll
            for (int m = 0; m < 4; ++m) {
                const int row = row0 + ai * 128 + m * 16; const float r = rsqrtf(memss[row] * (1.0f / 1024.0f) + 1e-6f);
#pragma unroll
                for (int bj = 0; bj < 2; ++bj) {
                    const size_t off = (size_t)row * 1024 + ct * 256 + bj * 128 + wc * 32 + fq * 8;
                    const f32x4 v0 = acc[ai][bj][m][0] * r, v1 = acc[ai][bj][m][1] * r;
                    *(f32x4*)(of + off) = v0; *(f32x4*)(of + off + 4) = v1;
                    u32x4 w; w.x = pk2(v0.x, v0.y); w.y = pk2(v0.z, v0.w); w.z = pk2(v1.x, v1.y); w.w = pk2(v1.z, v1.w);
                    *(u32x4*)(ob + off) = w;
                }
            }
    }
};

struct ThinResid {
    const float* Xin32; bf16* XB; float* slot; float scale;
    __device__ __forceinline__ float operator()(int row, int col, f32x4 acc) const {
        bf16* xb = XB + (size_t)row * D + col;
        f32x4 v;
        if (Xin32 != nullptr) v = *(const f32x4*)(Xin32 + (size_t)row * D + col);
        else { const u32x2 w0 = *(const u32x2*)xb; v = (f32x4){bflo(w0.x), bfhi(w0.x), bflo(w0.y), bfhi(w0.y)}; }
        v += scale * acc;
        u32x2 w; w.x = pk2(v.x, v.y); w.y = pk2(v.z, v.w); *(u32x2*)xb = w;
        const float y0 = bflo(w.x), y1 = bfhi(w.x), y2 = bflo(w.y), y3 = bfhi(w.y);
        return (y0 * y0 + y1 * y1) + (y2 * y2 + y3 * y3);
    }
    __device__ __forceinline__ void fin(int row, int ng, float ss) const { slot[(size_t)row * 16 + ng] = ss; }
};
struct ThinScale {
    bf16* O; const float* slot;
    __device__ __forceinline__ float operator()(int row, int col, f32x4 acc) const {
        const float r = rstd_of(slot, row);
        u32x2 w; w.x = pk2(acc.x * r, acc.y * r); w.y = pk2(acc.z * r, acc.w * r); *(u32x2*)(O + (size_t)row * D + col) = w;
        return 0.f;
    }
    __device__ __forceinline__ void fin(int, int, float) const {}
};
struct ThinScaleLd {
    bf16* O; int ld; const float* slot;
    __device__ __forceinline__ float operator()(int row, int col, f32x4 acc) const {
        const float r = rstd_of(slot, row);
        u32x2 w; w.x = pk2(acc.x * r, acc.y * r); w.y = pk2(acc.z * r, acc.w * r); *(u32x2*)(O + (size_t)row * ld + col) = w;
        return 0.f;
    }
    __device__ __forceinline__ void fin(int, int, float) const {}
};
struct ThinGate {
    float* Gt; const float* slot; int cbase;
    __device__ __forceinline__ float operator()(int row, int col, f32x4 acc) const {
        const int c = col - cbase;
        if (c == 0 || c == 4) { const float r = rstd_of(slot, row); *(f32x4*)(Gt + (size_t)row * 8 + c) = acc * r; }
        return 0.f;
    }
    __device__ __forceinline__ void fin(int, int, float) const {}
};
template <class TE, int NJ = 4>
__device__ __forceinline__ void thin_gemm_rc(ldsp lds, const bf16* A, const bf16* Bt, int K, int row0, int col0, int ng, const TE& E);
template <class TE>
__device__ __forceinline__ void thin_gemm(ldsp lds, const bf16* A, const bf16* Bt, int K, int unit, const TE& E) {
    thin_gemm_rc(lds, A, Bt, K, NP + 16 * (unit & 7), 64 * (unit >> 3), unit >> 3, E);
}
template <class TE, int NJ>
__device__ __forceinline__ void thin_gemm_rc(ldsp lds, const bf16* A, const bf16* Bt, int K, int row0, int col0, int ng, const TE& E) {
    const int tid = opaque_tid(), lane = tid & 63, wave = __builtin_amdgcn_readfirstlane(tid >> 6);
    const int kw = K >> 3, kbeg = wave * kw;
    f32x4 acc[NJ];
#pragma unroll
    for (int j = 0; j < NJ; ++j) acc[j] = (f32x4){0.f, 0.f, 0.f, 0.f};
#pragma unroll 4
    for (int k0 = kbeg; k0 < kbeg + kw; k0 += 32) {
        const bf16x8 Xf = gfrag(A, (size_t)K, row0, k0, lane);
#pragma unroll
        for (int j = 0; j < NJ; ++j) acc[j] = mfma16(gfrag(Bt, (size_t)K, col0 + 16 * j, k0, lane), Xf, acc[j]);
    }
    LAS f32x4* red = (LAS f32x4*)lds; LAS float* SS = (LAS float*)(lds + 32768);
#pragma unroll
    for (int j = 0; j < NJ; ++j) red[(wave * NJ + j) * 64 + lane] = acc[j];
    __syncthreads();
    if (wave < NJ) {
        f32x4 v = red[wave * 64 + lane];
#pragma unroll
        for (int w = 1; w < 8; ++w) v += red[(w * NJ + wave) * 64 + lane];
        float ss = E(row0 + (lane & 15), col0 + 16 * wave + 4 * (lane >> 4), v);
        ss += __shfl_xor(ss, 16); ss += __shfl_xor(ss, 32);
        if (lane < 16) SS[wave * 16 + lane] = ss;
    }
    __syncthreads();
    if (NJ == 4) { if (tid < 16) E.fin(row0 + tid, ng, (SS[tid] + SS[16 + tid]) + (SS[32 + tid] + SS[48 + tid])); }
    __syncthreads();
}

template <class TE>
__device__ __forceinline__ void thin_cols16(ldsp lds, const bf16* A, const bf16* Bt, int K, int row0, int col0, const TE& E) {
    const int tid = opaque_tid(), lane = tid & 63, wave = __builtin_amdgcn_readfirstlane(tid >> 6);
    const int kw = K >> 3, kbeg = wave * kw;
    f32x4 acc[4];
#pragma unroll
    for (int j = 0; j < 4; ++j) acc[j] = (f32x4){0.f, 0.f, 0.f, 0.f};
#pragma unroll 4
    for (int k0 = kbeg; k0 < kbeg + kw; k0 += 32) {
        const bf16x8 Bf = gfrag(Bt, (size_t)K, col0, k0, lane);
#pragma unroll
        for (int j = 0; j < 4; ++j) acc[j] = mfma16(Bf, gfrag(A, (size_t)K, row0 + 16 * j, k0, lane), acc[j]);
    }
    LAS f32x4* red = (LAS f32x4*)lds;
#pragma unroll
    for (int j = 0; j < 4; ++j) red[(wave * 4 + j) * 64 + lane] = acc[j];
    __syncthreads();
    if (wave < 4) {
        f32x4 v = red[wave * 64 + lane];
#pragma unroll
        for (int w = 1; w < 8; ++w) v += red[(w * 4 + wave) * 64 + lane];
        E(row0 + 16 * wave + (lane & 15), col0 + 4 * (lane >> 4), v);
    }
    __syncthreads();
}

template <int MODE> __device__ __forceinline__ int dst_row(int n) {
    if (MODE == 1) return n < 2816 ? ((n >> 7) * 256 + (n & 127)) : (((n - 2816) >> 7) * 256 + 128 + ((n - 2816) & 127));
    if (MODE == 2) return n < 5120 ? n : (n < 5152 ? 11264 + (n - 5120) : n - 32);
    if (MODE == 3) return n < 2048 ? n : (n < 2056 ? 3072 + (n - 2048) : n - 8);
    return n;
}
template <int MODE> __device__ __forceinline__ void tr_load(const float* W, int K, int N, const float* g, int glen, int item, int lane, f32x4 (&v)[16], f32x4 (&gq)[2]) {
    const int nblk = (N + 63) >> 6, kb = item / nblk, nb = item - kb * nblk, k0 = 64 * kb, n0 = 64 * nb;
    const int rr = lane >> 4, cc = 4 * (lane & 15);
    const int ncl = (n0 + cc < N) ? n0 + cc : 0;
#pragma unroll
    for (int i = 0; i < 16; ++i) v[i] = *(const f32x4*)(W + (size_t)(k0 + 4 * i + rr) * N + ncl);
    gq[0] = gq[1] = (f32x4){1.f, 1.f, 1.f, 1.f};
    if (g != nullptr && k0 < glen) { const f32x4* gp = (const f32x4*)(g + k0 + 8 * (lane & 7)); gq[0] = gp[0]; gq[1] = gp[1]; }
}
template <int MODE> __device__ __forceinline__ void tr_store(int K, int N, bf16* WT, int row_off, LAS float* scr, int item, int lane, const f32x4 (&v)[16], const f32x4 (&gq)[2]) {
    const int nblk = (N + 63) >> 6, kb = item / nblk, nb = item - kb * nblk, k0 = 64 * kb, n0 = 64 * nb;
    const int rr = lane >> 4, cc = 4 * (lane & 15);
#pragma unroll
    for (int i = 0; i < 16; ++i) { LAS float* d = scr + (4 * i + rr) * 65 + cc; d[0] = v[i].x; d[1] = v[i].y; d[2] = v[i].z; d[3] = v[i].w; }
    LDSW();
    const int c = lane & 7, nl = lane >> 3;
#pragma unroll
    for (int j = 0; j < 8; ++j) {
        const int n = nl + 8 * j; const LAS float* s = scr + (8 * c) * 65 + n;
        u32x4 o; o.x = pk2(s[0 * 65] * gq[0].x, s[1 * 65] * gq[0].y); o.y = pk2(s[2 * 65] * gq[0].z, s[3 * 65] * gq[0].w);
        o.z = pk2(s[4 * 65] * gq[1].x, s[5 * 65] * gq[1].y); o.w = pk2(s[6 * 65] * gq[1].z, s[7 * 65] * gq[1].w);
        if (n0 + n < N) *(u32x4*)(WT + (size_t)(row_off + dst_row<MODE>(n0 + n)) * K + k0 + 8 * c) = o;
    }
    LDSW();
}
template <int MODE> __device__ __forceinline__ void tr_item2(const float* W, int K, int N, bf16* WT, int row_off, const float* g, int glen, LAS float* scr, int it0, int it1, int ni, int lane) {
    f32x4 va[16], vb[16], ga[2], gb[2];
    tr_load<MODE>(W, K, N, g, glen, it0, lane, va, ga);
    if (it1 < ni) tr_load<MODE>(W, K, N, g, glen, it1, lane, vb, gb);
    tr_store<MODE>(K, N, WT, row_off, scr, it0, lane, va, ga);
    if (it1 < ni) tr_store<MODE>(K, N, WT, row_off, scr, it1, lane, vb, gb);
}
template <int SET>
__device__ __forceinline__ void convert_set(const Ctx& p, ldsp lds, int wg, int nwg) {
    const int tid = opaque_tid(), lane = tid & 63, wave = tid >> 6;
    unsigned char* ws = p.ws;
    LAS float* scr = (LAS float*)(lds + wave * 16640);
    const int gw = __builtin_amdgcn_readfirstlane(wg * 8 + wave), NGW = nwg * 8;
#define TR_MAT(MODE, W, K, N, WT, ROFF, GP, GLEN) { const int ni = ((K) / 64) * (((N) + 63) / 64); \
        if constexpr (SET == 0) { for (int it = gw; it < ni; it += 2 * NGW) tr_item2<MODE>((W), (K), (N), (bf16*)(WT), (ROFF), (GP), (GLEN), scr, it, it + NGW, ni, lane); } \
        else { for (int it = gw; it < ni; it += NGW) { f32x4 va[16], ga[2]; tr_load<MODE>((W), (K), (N), (GP), (GLEN), it, lane, va, ga); tr_store<MODE>((K), (N), (bf16*)(WT), (ROFF), scr, it, lane, va, ga); } } }
#define TR_W1IN(l)  TR_MAT(1, p.in(12) + (size_t)(l) * 1024 * 5632, 1024, 5632, ws + WS_W1IN + (l) * SZ_WIN, 0, p.in(11) + (l) * 1024, 1024)
#define TR_W2IN(l)  TR_MAT(1, p.in(34) + (size_t)(l) * 1024 * 5632, 1024, 5632, ws + WS_W2IN + (l) * SZ_WIN, 0, p.in(33) + (l) * 1024, 1024)
#define TR_W1OUT(l) TR_MAT(0, p.in(13) + (size_t)(l) * 2816 * 1024, 2816, 1024, ws + WS_W1OUT + (l) * SZ_WOUT, 0, (const float*)nullptr, 0)
#define TR_W2OUT(l) TR_MAT(0, p.in(35) + (size_t)(l) * 2816 * 1024, 2816, 1024, ws + WS_W2OUT + (l) * SZ_WOUT, 0, (const float*)nullptr, 0)
#define TR_WXQ(l)   TR_MAT(0, p.in(30) + (size_t)(l) * 1024 * 1024, 1024, 1024, ws + WS_WXQ + (l) * SZ_SQ, 0, p.in(28) + (l) * 1024, 1024)
#define TR_WXO(l)   TR_MAT(0, p.in(32) + (size_t)(l) * 1024 * 1024, 1024, 1024, ws + WS_WXO + (l) * SZ_SQ, 0, (const float*)nullptr, 0)
#define TR_WXKV(l)  TR_MAT(0, p.in(31) + (size_t)(l) * 1024 * 2048, 1024, 2048, ws + WS_WXKV, 2048 * (l), p.in(29) + (l) * 1024, 1024)
    if constexpr (SET == 0) {
        TR_W1IN(0)
        TR_MAT(2, p.in(15), 1024, 11296, ws + WS_WINAB, 0, p.in(14), 1024)
        TR_WXKV(0) TR_WXKV(1)
        TR_MAT(0, p.in(22), 4096, 1024, ws + WS_WOUTAB, 0, p.in(21), 2048)
    }
    if constexpr (SET == 1) { TR_W1OUT(0) TR_W2IN(0) TR_WXQ(0) TR_WXO(0) }
    if constexpr (SET == 2) {
        TR_W2OUT(0) TR_W1IN(1)
        TR_MAT(0, p.in(27), 1024, 1024, ws + WS_WOUTC, 0, p.in(26), 1024)
        TR_WXQ(1) TR_WXO(1)
    }
    if constexpr (SET == 3) {
        TR_W1OUT(1) TR_W2IN(1)
        TR_MAT(3, p.in(23), 1024, 3080, ws + WS_WINC, 0, p.in(14) + 1024, 1024)
    }
    if constexpr (SET == 4) { TR_W2OUT(1) }
#undef TR_MAT
#undef TR_W1IN
#undef TR_W2IN
#undef TR_W1OUT
#undef TR_W2OUT
#undef TR_WXQ
#undef TR_WXO
#undef TR_WXKV
}
template <unsigned PM>
__device__ __forceinline__ void prologue(const Ctx& p, ldsp lds, int vcu, int G) {
    const int tid = opaque_tid(), lane = tid & 63, wave = tid >> 6;
    unsigned char* ws = p.ws;
    const int gw = vcu * 8 + wave, NGW = G * 8;
    if constexpr ((PM & 1u) != 0) convert_set<0>(p, lds, vcu, G);
    if constexpr ((PM & 2u) != 0) {
    bf16* XB = (bf16*)(ws + WS_XB); float* slot = (float*)(ws + WS_SLOT);
    for (int row = gw; row < MP; row += 2 * NGW) {
        f32x4 v[2][4]; float ss[2] = {0.f, 0.f};
#pragma unroll
        for (int q = 0; q < 2; ++q) {
            const int r = row + q * NGW;
            const int rc = r < MR ? r : 0;
            const f32x4* src = (const f32x4*)(rc < NP ? p.in(0) + (size_t)rc * D : p.in(1) + (size_t)(rc - NP) * D) + lane;
#pragma unroll
            for (int j = 0; j < 4; ++j) v[q][j] = src[64 * j];
        }
#pragma unroll
        for (int q = 0; q < 2; ++q) {
            const int r = row + q * NGW;
            if (r < MP) {
#pragma unroll
                for (int j = 0; j < 4; ++j) { if (r >= MR) v[q][j] = (f32x4){0.f, 0.f, 0.f, 0.f}; ss[q] += (v[q][j].x * v[q][j].x + v[q][j].y * v[q][j].y) + (v[q][j].z * v[q][j].z + v[q][j].w * v[q][j].w); }
                const float tot = wave_sum(ss[q]);
                u32x2* bo = (u32x2*)(XB + (size_t)r * D) + lane;
#pragma unroll
                for (int j = 0; j < 4; ++j) { u32x2 w; w.x = pk2(v[q][j].x, v[q][j].y); w.y = pk2(v[q][j].z, v[q][j].w); bo[64 * j] = w; }
                if (lane < 16) slot[(size_t)r * 16 + lane] = lane == 0 ? tot : 0.f;
            }
        }
    }
    }
}
__device__ __forceinline__ void prologue_mem(const Ctx& p, int vcu, int G) {
    const int tid = opaque_tid(), lane = tid & 63, wave = tid >> 6;
    unsigned char* ws = p.ws;
    const int gw = vcu * 8 + wave, NGW = G * 8;
    {
    bf16* MB = (bf16*)(ws + WS_MEMB); float* mss = (float*)(ws + WS_MEMSS);
    for (int row = gw; row < 2048; row += NGW) {
        const f32x4* src = (const f32x4*)(p.in(10) + (size_t)row * D) + lane; float ss = 0.f; u32x2* bo = (u32x2*)(MB + (size_t)row * D) + lane;
#pragma unroll
        for (int j = 0; j < 4; ++j) { const f32x4 v = src[64 * j]; ss += (v.x * v.x + v.y * v.y) + (v.z * v.z + v.w * v.w); u32x2 w; w.x = pk2(v.x, v.y); w.y = pk2(v.z, v.w); bo[64 * j] = w; }
        ss = wave_sum(ss);
        if (lane == 0) mss[row] = ss;
    }
    f32x2* rot = (f32x2*)(ws + WS_ROT);
    for (int idx = vcu * 512 + tid; idx < 2049 * 128; idx += G * 512) {
        const int i = idx & 127, pr = idx >> 7; const int pos = pr == 2048 ? 16384 : pr;
        double inv = 1.0, bs = 0.9305720409296989; int e = i;
        while (e) { if (e & 1) inv *= bs; bs *= bs; e >>= 1; }
        const double rev = (double)pos * inv * 0.15915494309189535;
        const float fr = (float)(rev - floor(rev));
        rot[idx] = (f32x2){__builtin_amdgcn_cosf(fr), __builtin_amdgcn_sinf(fr)};
    }
    }
}
__device__ __forceinline__ void conv_unit(const Ctx& p, int u) {
    const int tid = opaque_tid();
    unsigned char* ws = p.ws;
    const bf16* P = (const bf16*)(ws + WS_P); bf16* XC = (bf16*)(ws + WS_XC);
    const float* cw = p.in(16); const float* cb = p.in(17);
    const int b = u >> 5, blk = u & 31;
    if (tid < 384) {
        const int c0 = 8 * tid;
        v2f w[4][4], bb[4];
#pragma unroll
        for (int j = 0; j < 4; ++j) { const f32x4 wa = *(const f32x4*)(cw + j * 3072 + c0), wb = *(const f32x4*)(cw + j * 3072 + c0 + 4);
            w[j][0] = (v2f){wa.x, wa.y}; w[j][1] = (v2f){wa.z, wa.w}; w[j][2] = (v2f){wb.x, wb.y}; w[j][3] = (v2f){wb.z, wb.w}; }
        { const f32x4 ba = *(const f32x4*)(cb + c0), bc = *(const f32x4*)(cb + c0 + 4); bb[0] = (v2f){ba.x, ba.y}; bb[1] = (v2f){ba.z, ba.w}; bb[2] = (v2f){bc.x, bc.y}; bb[3] = (v2f){bc.z, bc.w}; }
        const size_t row0 = (size_t)b * SEQ + 64 * blk;
        const bf16* src = P + row0 * NAB + PX + c0; bf16* dst = XC + row0 * 3072 + c0;
        v2f win[3][4];
#pragma unroll
        for (int j = 0; j < 3; ++j) { const u32x4 t = blk > 0 ? *(const u32x4*)(src - (size_t)(3 - j) * NAB) : (u32x4){0u, 0u, 0u, 0u};
            win[j][0] = (v2f){bflo(t.x), bfhi(t.x)}; win[j][1] = (v2f){bflo(t.y), bfhi(t.y)}; win[j][2] = (v2f){bflo(t.z), bfhi(t.z)}; win[j][3] = (v2f){bflo(t.w), bfhi(t.w)}; }
#pragma unroll 1
        for (int r0 = 0; r0 < 64; r0 += 8) {
            u32x4 cur[8];
#pragma unroll
            for (int r = 0; r < 8; ++r) cur[r] = *(const u32x4*)(src + (size_t)(r0 + r) * NAB);
#pragma unroll
            for (int r = 0; r < 8; ++r) {
                v2f x3[4]; x3[0] = (v2f){bflo(cur[r].x), bfhi(cur[r].x)}; x3[1] = (v2f){bflo(cur[r].y), bfhi(cur[r].y)}; x3[2] = (v2f){bflo(cur[r].z), bfhi(cur[r].z)}; x3[3] = (v2f){bflo(cur[r].w), bfhi(cur[r].w)};
                unsigned ow[4];
#pragma unroll
                for (int k = 0; k < 4; ++k) {
                    const v2f av = bb[k] + w[0][k] * win[0][k] + w[1][k] * win[1][k] + w[2][k] * win[2][k] + w[3][k] * x3[k];
                    const v2f t = av * -1.44269504089f;
                    v2f ex; ex.x = __builtin_amdgcn_exp2f(t.x); ex.y = __builtin_amdgcn_exp2f(t.y);
                    const v2f dn = ex + 1.0f;
                    v2f rq; rq.x = __builtin_amdgcn_rcpf(dn.x); rq.y = __builtin_amdgcn_rcpf(dn.y);
                    const v2f o = av * rq;
                    ow[k] = pk2(o.x, o.y);
                }
                *(u32x4*)(dst + (size_t)(r0 + r) * 3072) = (u32x4){ow[0], ow[1], ow[2], ow[3]};
#pragma unroll
                for (int k = 0; k < 4; ++k) { win[0][k] = win[1][k]; win[1][k] = win[2][k]; win[2][k] = x3[k]; }
            }
        }
        if (blk == 31) {
            float* co = p.out + O_CONVP + (size_t)b * 3 * 3072 + c0;
#pragma unroll
            for (int j = 0; j < 3; ++j) { *(f32x4*)(co + j * 3072) = (f32x4){win[j][0].x, win[j][0].y, win[j][1].x, win[j][1].y}; *(f32x4*)(co + j * 3072 + 4) = (f32x4){win[j][2].x, win[j][2].y, win[j][3].x, win[j][3].y}; }
        }
    }
    if (tid >= 320) {
        const int id = u * 192 + (tid - 320), i = id / 384, c0 = 8 * (id - i * 384);
        const size_t row = NP + i;
        const float* buf = p.in(4) + (size_t)i * 3 * 3072 + c0; float* co = p.out + O_CONVS + (size_t)i * 3 * 3072 + c0;
        float uu[8], o[8]; unpack8(*(const u32x4*)(P + row * NAB + PX + c0), uu);
#pragma unroll
        for (int hh = 0; hh < 2; ++hh) {
            const f32x4 b0 = *(const f32x4*)(buf + 4 * hh), b1 = *(const f32x4*)(buf + 3072 + 4 * hh), b2 = *(const f32x4*)(buf + 2 * 3072 + 4 * hh);
            const f32x4 w0 = *(const f32x4*)(cw + c0 + 4 * hh), w1 = *(const f32x4*)(cw + 3072 + c0 + 4 * hh), w2 = *(const f32x4*)(cw + 2 * 3072 + c0 + 4 * hh), w3 = *(const f32x4*)(cw + 3 * 3072 + c0 + 4 * hh);
            const f32x4 bs = *(const f32x4*)(cb + c0 + 4 * hh), uv = (f32x4){uu[4 * hh], uu[4 * hh + 1], uu[4 * hh + 2], uu[4 * hh + 3]};
            const f32x4 acc = bs + w0 * b0 + w1 * b1 + w2 * b2 + w3 * uv;
#pragma unroll
            for (int e = 0; e < 4; ++e) o[4 * hh + e] = siluf(acc[e]);
            *(f32x4*)(co + 4 * hh) = b1; *(f32x4*)(co + 3072 + 4 * hh) = b2; *(f32x4*)(co + 2 * 3072 + 4 * hh) = uv;
        }
        *(u32x4*)(XC + row * 3072 + c0) = pack8(o);
    }
}
__device__ __forceinline__ float ssd_dt_scan(const float* DT, size_t row0, int h, float bias, float a, LAS float* cs, LAS float* dtv, int lane) {
    const int s0 = 2 * lane;
    const float dt0 = softplusf(DT[(row0 + s0) * 32 + h] + bias), dt1 = softplusf(DT[(row0 + s0 + 1) * 32 + h] + bias);
    const float da0 = dt0 * a, da1 = dt1 * a;
    float v = da0 + da1;
#pragma unroll
    for (int o = 1; o < 64; o <<= 1) { const float t = __shfl_up(v, o); if (lane >= o) v += t; }
    cs[s0] = v - da1; cs[s0 + 1] = v; dtv[s0] = dt0; dtv[s0 + 1] = dt1;
    return __shfl(v, 63);
}

__device__ __forceinline__ void ssdA_unit(const Ctx& p, ldsp lds, int b, int h) {
    const int tid = opaque_tid(), lane = tid & 63, wave = __builtin_amdgcn_readfirstlane(tid >> 6), g = h >> 3;
    unsigned char* ws = p.ws;
    const bf16* XC = (const bf16*)(ws + WS_XC); const float* DT = (const float*)(ws + WS_DT); bf16* HC = (bf16*)(ws + WS_HC);
    ldsp XW = lds; ldsp BI = lds + 18432;
    LAS float* CS = (LAS float*)(lds + 53248); LAS float* DTV = (LAS float*)(lds + 61440); LAS float* TOTS = (LAS float*)(lds + 69632);
    {
        const float bias = p.in(18)[h], a = -expf(p.in(19)[h]);
#pragma unroll 1
        for (int cc = wave; cc < 16; cc += 8) { const float tot = ssd_dt_scan(DT, (size_t)b * SEQ + cc * 128, h, bias, a, CS + cc * 128, DTV + cc * 128, lane); if (lane == 0) TOTS[cc] = tot; }
    }
    const int pi = wave & 3, nj0 = (wave >> 2) * 4;
    const bf16* Px = XC + (size_t)b * SEQ * 3072 + 64 * h + 8 * (tid & 7); const bf16* Pbb = XC + (size_t)b * SEQ * 3072 + 2048 + 128 * g + 8 * (tid & 15);
    u32x4 rx[2][2], rb[2][4];
#define SSDA_LOAD(par, c_) { _Pragma("unroll") for (int i = 0; i < 2; ++i) rx[par][i] = *(const u32x4*)(Px + (size_t)((c_) * 128 + ((tid + 512 * i) >> 3)) * 3072); \
        _Pragma("unroll") for (int i = 0; i < 4; ++i) rb[par][i] = *(const u32x4*)(Pbb + (size_t)((c_) * 128 + ((tid + 512 * i) >> 4)) * 3072); }
    SSDA_LOAD(0, 0) SSDA_LOAD(1, 1)
    f32x4 acc[4];
#pragma unroll
    for (int j = 0; j < 4; ++j) acc[j] = (f32x4){0.f, 0.f, 0.f, 0.f};
    __syncthreads();
#pragma unroll 2
    for (int c = 0; c < 16; ++c) {
        const int par = c & 1;
        const float tot = TOTS[c];
#pragma unroll
        for (int i = 0; i < 2; ++i) {
            const int s = (tid + 512 * i) >> 3; float o[8]; unpack8(par ? rx[1][i] : rx[0][i], o);
            const float w = __expf(tot - CS[c * 128 + s]) * DTV[c * 128 + s];
#pragma unroll
            for (int e = 0; e < 8; ++e) o[e] *= w;
            *(LAS u32x4*)(XW + s * 144 + (tid & 7) * 16) = pack8(o);
        }
#pragma unroll
        for (int i = 0; i < 4; ++i) *(LAS u32x4*)(BI + ((tid + 512 * i) >> 4) * 272 + (tid & 15) * 16) = par ? rb[1][i] : rb[0][i];
        __syncthreads();
        if (c < 14) { if (par) SSDA_LOAD(1, c + 2) else SSDA_LOAD(0, c + 2) }
        {
            bf16* hc = HC + (((size_t)(b * 32 + h) * 16 + c) * 64) * 128;
#pragma unroll
            for (int j = 0; j < 4; ++j) { u32x2 w; w.x = pk2(acc[j][0], acc[j][1]); w.y = pk2(acc[j][2], acc[j][3]);
                *(u32x2*)(hc + (16 * pi + (lane & 15)) * 128 + 16 * (nj0 + j) + 4 * (lane >> 4)) = w; }
        }
        const float dec = __expf(tot);
#pragma unroll
        for (int j = 0; j < 4; ++j) acc[j] *= dec;
#pragma unroll
        for (int ks = 0; ks < 4; ++ks) {
            const bf16x8 Xf = trfrag(XW, 144, 32 * ks, 16 * pi, lane);
#pragma unroll
            for (int j = 0; j < 4; ++j) acc[j] = mfma16(trfrag(BI, 272, 32 * ks, 16 * (nj0 + j), lane), Xf, acc[j]);
        }
        __syncthreads();
    }
#undef SSDA_LOAD
    float* so = p.out + O_SSMP + ((size_t)(b * 32 + h) * 64) * 128;
#pragma unroll
    for (int j = 0; j < 4; ++j) *(f32x4*)(so + (16 * pi + (lane & 15)) * 128 + 16 * (nj0 + j) + 4 * (lane >> 4)) = acc[j];
}

__device__ __forceinline__ void retA_unit(const Ctx& p, ldsp lds, int b, int h, int dvs) {
    const int tid = opaque_tid(), lane = tid & 63, wave = __builtin_amdgcn_readfirstlane(tid >> 6);
    unsigned char* ws = p.ws;
    const bf16* P = (const bf16*)(ws + WS_P); bf16* SC = (bf16*)(ws + WS_SC);
    ldsp KW = lds; ldsp VI = lds + 67584;
    const float lg2 = log2f(1.f - exp2f(-5.f - (float)h));
    const float g128 = exp2f(128.f * lg2);
    f32x4 acc[2][4];
#pragma unroll
    for (int i = 0; i < 2; ++i)
#pragma unroll
        for (int j = 0; j < 4; ++j) acc[i][j] = (f32x4){0.f, 0.f, 0.f, 0.f};
    const bf16* Pk = P + (size_t)b * SEQ * NAB + PRK + 256 * h + 8 * (tid & 31); const bf16* Pv = P + (size_t)b * SEQ * NAB + PRV + 512 * h + 64 * dvs + 8 * (tid & 7);
    u32x4 rk[2][8], rv[2][2];
#define RETA_LOAD(par, c_) { _Pragma("unroll") for (int i = 0; i < 8; ++i) rk[par][i] = *(const u32x4*)(Pk + (size_t)((c_) * 128 + ((tid + 512 * i) >> 5)) * NAB); \
        _Pragma("unroll") for (int i = 0; i < 2; ++i) rv[par][i] = *(const u32x4*)(Pv + (size_t)((c_) * 128 + ((tid + 512 * i) >> 3)) * NAB); }
    RETA_LOAD(0, 0) RETA_LOAD(1, 1)
#pragma unroll 2
    for (int c = 0; c < 16; ++c) {
        const int par = c & 1;
#pragma unroll
        for (int i = 0; i < 8; ++i) {
            const int s = (tid + 512 * i) >> 5; float k[8]; unpack8(par ? rk[1][i] : rk[0][i], k);
            const float w = exp2f((float)(127 - s) * lg2);
#pragma unroll
            for (int e = 0; e < 8; ++e) k[e] *= w;
            *(LAS u32x4*)(KW + s * 528 + (tid & 31) * 16) = pack8(k);
        }
#pragma unroll
        for (int i = 0; i < 2; ++i) *(LAS u32x4*)(VI + ((tid + 512 * i) >> 3) * 144 + (tid & 7) * 16) = par ? rv[1][i] : rv[0][i];
        __syncthreads();
        if (c < 14) { if (par) RETA_LOAD(1, c + 2) else RETA_LOAD(0, c + 2) }
        {
            bf16* sc = SC + (((size_t)(b * 4 + h) * 16 + c) * 512) * 256;
#pragma unroll
            for (int i = 0; i < 2; ++i)
#pragma unroll
                for (int j = 0; j < 4; ++j) { u32x2 w; w.x = pk2(acc[i][j][0], acc[i][j][1]); w.y = pk2(acc[i][j][2], acc[i][j][3]);
                    *(u32x2*)(sc + (size_t)(64 * dvs + 16 * j + (lane & 15)) * 256 + 16 * (2 * wave + i) + 4 * (lane >> 4)) = w; }
        }
#pragma unroll
        for (int i = 0; i < 2; ++i)
#pragma unroll
            for (int j = 0; j < 4; ++j) acc[i][j] *= g128;
#pragma unroll
        for (int ks = 0; ks < 4; ++ks) {
            const bf16x8 A0 = trfrag(KW, 528, 32 * ks, 16 * (2 * wave), lane), A1 = trfrag(KW, 528, 32 * ks, 16 * (2 * wave + 1), lane);
#pragma unroll
            for (int j = 0; j < 4; ++j) { const bf16x8 B = trfrag(VI, 144, 32 * ks, 16 * j, lane); acc[0][j] = mfma16(A0, B, acc[0][j]); acc[1][j] = mfma16(A1, B, acc[1][j]); }
        }
        __syncthreads();
    }
#undef RETA_LOAD
    float* so = p.out + O_RETP + ((size_t)(b * 4 + h) * 256) * 512;
#pragma unroll
    for (int i = 0; i < 2; ++i)
#pragma unroll
        for (int j = 0; j < 4; ++j)
#pragma unroll
            for (int r = 0; r < 4; ++r) so[(size_t)(16 * (2 * wave + i) + 4 * (lane >> 4) + r) * 512 + 64 * dvs + 16 * j + (lane & 15)] = acc[i][j][r];
}

__device__ __forceinline__ float block_sum8(float v, LAS float* red, int lane, int wave) {
    v = wave_sum(v);
    __syncthreads();
    if (lane == 0) red[wave] = v;
    __syncthreads();
    return ((red[0] + red[1]) + (red[2] + red[3])) + ((red[4] + red[5]) + (red[6] + red[7]));
}

__device__ __forceinline__ void ssdS_unit(const Ctx& p, ldsp lds, int b, int g) {
    const int tid = opaque_tid(), lane = tid & 63, wave = __builtin_amdgcn_readfirstlane(tid >> 6);
    unsigned char* ws = p.ws;
    const bf16* P = (const bf16*)(ws + WS_P); const float* DT = (const float*)(ws + WS_DT); bf16* Y = (bf16*)(ws + WS_R3);
    const size_t row = NP + b;
    LAS float* XS = (LAS float*)lds; LAS float* BS = XS + 512; LAS float* CS = BS + 128; LAS float* YS = CS + 128; LAS float* DTS = YS + 512; LAS float* DAS = DTS + 8; LAS float* RED = DAS + 8;
    const bf16* XC = (const bf16*)(ws + WS_XC);
    for (int ci = tid; ci < 768; ci += 512) {
        const int xc = ci < 512 ? 512 * g + ci : (ci < 640 ? 2048 + 128 * g + (ci - 512) : 2560 + 128 * g + (ci - 640));
        XS[ci] = bf2f(XC[row * 3072 + xc]);
    }
    if (tid < 8) { const int h = 8 * g + tid; const float dt = softplusf(DT[row * 32 + h] + p.in(18)[h]); DTS[tid] = dt; DAS[tid] = expf(dt * (-expf(p.in(19)[h]))); }
    __syncthreads();
    const int pp = tid >> 3, ng = tid & 7;
#pragma unroll 1
    for (int h2 = 0; h2 < 8; h2 += 2) {
        f32x4 sv[2][4];
#pragma unroll
        for (int e = 0; e < 2; ++e) { const f32x4* si = (const f32x4*)(p.in(5) + (((size_t)b * 32 + 8 * g + h2 + e) * 64 + pp) * 128 + ng * 16);
#pragma unroll
            for (int q = 0; q < 4; ++q) sv[e][q] = ldnt4((const float*)(si + q)); }
#pragma unroll
        for (int e = 0; e < 2; ++e) {
            const int hh = h2 + e, h = 8 * g + hh;
            f32x4* so = (f32x4*)(p.out + O_SSMS + (((size_t)b * 32 + h) * 64 + pp) * 128 + ng * 16);
            const float x = XS[64 * hh + pp], dt = DTS[hh], dA = DAS[hh], xd = x * dt;
            float y = 0.f;
#pragma unroll
            for (int q = 0; q < 4; ++q) {
                const f32x4 Bv = *(const LAS f32x4*)(BS + ng * 16 + 4 * q), Cv = *(const LAS f32x4*)(CS + ng * 16 + 4 * q);
                const f32x4 nsv = sv[e][q] * dA + xd * Bv; stnt4((float*)(so + q), nsv);
                y += (nsv.x * Cv.x + nsv.y * Cv.y) + (nsv.z * Cv.z + nsv.w * Cv.w);
            }
            y += __shfl_xor(y, 1); y += __shfl_xor(y, 2); y += __shfl_xor(y, 4);
            if (ng == 0) { const float z = bf2f(P[row * NAB + PZ + 64 * h + pp]); YS[64 * hh + pp] = (y + x * p.in(20)[h]) * siluf(z); }
        }
    }
    __syncthreads();
    const float yv = YS[tid];
    const float tot = block_sum8(yv * yv, RED, lane, wave);
    Y[row * 4096 + 512 * g + tid] = (bf16)(pk2(yv * rsqrtf(tot * (1.f / 512.f) + 1e-6f), 0.f) & 0xffffu);
    __syncthreads();
}

__device__ __forceinline__ void retS_unit(const Ctx& p, ldsp lds, int b, int h) {
    const int tid = opaque_tid(), lane = tid & 63, wave = __builtin_amdgcn_readfirstlane(tid >> 6);
    unsigned char* ws = p.ws;
    const bf16* P = (const bf16*)(ws + WS_P); bf16* Y = (bf16*)(ws + WS_R3);
    const size_t row = NP + b;
    LAS float* QS = (LAS float*)lds; LAS float* KS = QS + 256; LAS float* VS = KS + 256; LAS float* RD = VS + 512; LAS float* RED = RD + 2048;
    const int dvq = tid & 127, dkg = tid >> 7;
    const size_t sb = ((size_t)(b * 4 + h) * 256) * 512 + 4 * dvq;
    const float* si = p.in(6) + sb; float* so = p.out + O_RETS + sb;
    f32x4 s[16];
#pragma unroll
    for (int j = 0; j < 16; ++j) s[j] = ldnt4(si + (size_t)(dkg + 4 * j) * 512);
    if (tid < 256) { QS[tid] = bf2f(P[row * NAB + PRQ + 256 * h + tid]); KS[tid] = bf2f(P[row * NAB + PRK + 256 * h + tid]); }
    VS[tid] = bf2f(P[row * NAB + PRV + 512 * h + tid]);
    __syncthreads();
    const float gam = 1.f - exp2f(-5.f - (float)h);
    const f32x4 v4 = *(const LAS f32x4*)(VS + 4 * dvq);
    f32x4 o4 = (f32x4){0.f, 0.f, 0.f, 0.f};
#pragma unroll 1
    for (int i0 = 0; i0 < 64; i0 += 16) {
        if (i0 > 0) {
#pragma unroll
            for (int j = 0; j < 16; ++j) s[j] = ldnt4(si + (size_t)(dkg + 4 * (i0 + j)) * 512);
        }
#pragma unroll
        for (int j = 0; j < 16; ++j) {
            const int dk = dkg + 4 * (i0 + j);
            const f32x4 nsv = gam * s[j] + KS[dk] * v4;
            stnt4(so + (size_t)dk * 512, nsv);
            o4 += QS[dk] * nsv;
        }
    }
    *(LAS f32x4*)(RD + dkg * 512 + 4 * dvq) = o4;
    __syncthreads();
    const float o = (RD[tid] + RD[512 + tid]) + (RD[1024 + tid] + RD[1536 + tid]);
    const float tot = block_sum8(o * o, RED, lane, wave);
    const float rg = bf2f(P[row * NAB + PRG + 512 * h + tid]);
    Y[row * 4096 + 2048 + 512 * h + tid] = (bf16)(pk2(siluf(rg) * o * rsqrtf(tot * (1.f / 512.f) + 1e-6f), 0.f) & 0xffffu);
    __syncthreads();
}

__device__ __forceinline__ void ssdB_unit(const Ctx& p, ldsp lds, int b, int g, int c) {
    const int tid = opaque_tid(), lane = tid & 63, wave = __builtin_amdgcn_readfirstlane(tid >> 6);
    unsigned char* ws = p.ws;
    const bf16* P = (const bf16*)(ws + WS_P); const bf16* XC = (const bf16*)(ws + WS_XC); const float* DT = (const float*)(ws + WS_DT); const bf16* HC = (const bf16*)(ws + WS_HC); bf16* Y = (bf16*)(ws + WS_R3);
    ldsp CI = lds; ldsp BI = lds + 34816; ldsp XD = lds + 34816; ldsp HI = lds + 53248;
    LAS float* CSH = (LAS float*)(lds + 70656); LAS float* DTH = (LAS float*)(lds + 74752);
    const size_t row0 = (size_t)b * SEQ + c * 128;
    {
        u32x4 rb[4], rc[4];
#pragma unroll
        for (int i = 0; i < 4; ++i) { const bf16* src = XC + (row0 + ((tid + 512 * i) >> 4)) * 3072 + 2048 + 128 * g + 8 * (tid & 15); rb[i] = *(const u32x4*)src; rc[i] = *(const u32x4*)(src + 512); }
        { const int h = 8 * g + wave; (void)ssd_dt_scan(DT, row0, h, p.in(18)[h], -expf(p.in(19)[h]), CSH + wave * 128, DTH + wave * 128, lane); }
#pragma unroll
        for (int i = 0; i < 4; ++i) { const int s = (tid + 512 * i) >> 4, cg = tid & 15; *(LAS u32x4*)(BI + s * 272 + cg * 16) = rb[i]; *(LAS u32x4*)(CI + s * 272 + cg * 16) = rc[i]; }
    }
    u32x4 rx[2], rh[2]; u32x2 rz[4];
    const bf16* zsrc = P + (row0 + 16 * wave + (lane & 15)) * NAB + PZ + 512 * g + 4 * (lane >> 4);
    const bf16* xsrc = XC + (row0 + (tid >> 3)) * 3072 + 512 * g + 8 * (tid & 7);
    const bf16* hsrc = HC + (((size_t)(b * 32 + 8 * g) * 16 + c) * 64) * 128 + (tid >> 4) * 128 + (tid & 15) * 8;
#pragma unroll
    for (int i = 0; i < 2; ++i) { rx[i] = *(const u32x4*)(xsrc + (size_t)i * 64 * 3072); rh[i] = *(const u32x4*)(hsrc + i * 32 * 128); }
#pragma unroll
    for (int pj = 0; pj < 4; ++pj) rz[pj] = *(const u32x2*)(zsrc + 16 * pj);
    __syncthreads();
    f32x4 ST[8];
#pragma unroll
    for (int sj = 0; sj < 8; ++sj) ST[sj] = (f32x4){0.f, 0.f, 0.f, 0.f};
    bf16x8 CF[4];
#pragma unroll
    for (int ks = 0; ks < 4; ++ks) CF[ks] = rowfrag(CI, 272, 16 * wave, 32 * ks, lane);
#pragma unroll
    for (int sj = 0; sj < 8; ++sj) if (sj <= wave) {
#pragma unroll
        for (int ks = 0; ks < 4; ++ks) ST[sj] = mfma16(rowfrag(BI, 272, 16 * sj, 32 * ks, lane), CF[ks], ST[sj]);
    }
    __syncthreads();
    const int tl = 16 * wave + (lane & 15);
    float ss = 0.f;
#pragma unroll 1
    for (int hh = 0; hh < 8; ++hh) {
        const int h = 8 * g + hh;
#pragma unroll
        for (int i = 0; i < 2; ++i) {
            const int s = (tid + 512 * i) >> 3; float o[8]; unpack8(rx[i], o);
            const float w = DTH[hh * 128 + s];
#pragma unroll
            for (int e = 0; e < 8; ++e) o[e] *= w;
            *(LAS u32x4*)(XD + s * 144 + (tid & 7) * 16) = pack8(o);
            *(LAS u32x4*)(HI + ((tid + 512 * i) >> 4) * 272 + (tid & 15) * 16) = rh[i];
        }
        u32x2 zc[4];
#pragma unroll
        for (int pj = 0; pj < 4; ++pj) zc[pj] = rz[pj];
        __syncthreads();
        if (hh < 7) {
#pragma unroll
            for (int pj = 0; pj < 4; ++pj) rz[pj] = *(const u32x2*)(zsrc + 64 * (hh + 1) + 16 * pj);
#pragma unroll
            for (int i = 0; i < 2; ++i) { rx[i] = *(const u32x4*)(xsrc + 64 * (hh + 1) + (size_t)i * 64 * 3072); rh[i] = *(const u32x4*)(hsrc + (size_t)(hh + 1) * 16 * 64 * 128 + i * 32 * 128); }
        }
        const LAS float* csh = CSH + hh * 128;
        const float cst = csh[tl];
        f32x4 yT[4], yI[4];
#pragma unroll
        for (int pj = 0; pj < 4; ++pj) { yT[pj] = (f32x4){0.f, 0.f, 0.f, 0.f}; yI[pj] = (f32x4){0.f, 0.f, 0.f, 0.f}; }
#pragma unroll
        for (int ks = 0; ks < 4; ++ks) if (2 * ks <= wave) {
            f32x4 pa, pb;
#pragma unroll
            for (int r = 0; r < 4; ++r) {
                const int s0 = 32 * ks + 4 * (lane >> 4) + r, s1 = s0 + 16;
                pa[r] = s0 <= tl ? ST[2 * ks][r] * __expf(cst - csh[s0]) : 0.f;
                pb[r] = s1 <= tl ? ST[2 * ks + 1][r] * __expf(cst - csh[s1]) : 0.f;
            }
            const bf16x8 Pf = packP(pa, pb);
#pragma unroll
            for (int pj = 0; pj < 4; ++pj) yT[pj] = mfma16(trfragp(XD, 144, 32 * ks, 16 * pj, lane), Pf, yT[pj]);
        }
#pragma unroll
        for (int ks = 0; ks < 4; ++ks)
#pragma unroll
            for (int pj = 0; pj < 4; ++pj) yI[pj] = mfma16(rowfrag(HI, 272, 16 * pj, 32 * ks, lane), CF[ks], yI[pj]);
        const float ecs = __expf(cst), dsk = p.in(20)[h] / DTH[hh * 128 + tl];
#pragma unroll
        for (int pj = 0; pj < 4; ++pj) {
            const int pc = 16 * pj + 4 * (lane >> 4);
            const u32x2 xw = *(const LAS u32x2*)(XD + tl * 144 + pc * 2);
            const u32x2 zw = zc[pj];
            const float xv[4] = {bflo(xw.x), bfhi(xw.x), bflo(xw.y), bfhi(xw.y)}, zv[4] = {bflo(zw.x), bfhi(zw.x), bflo(zw.y), bfhi(zw.y)};
            float yv[4];
#pragma unroll
            for (int r = 0; r < 4; ++r) { yv[r] = (yT[pj][r] + ecs * yI[pj][r] + dsk * xv[r]) * siluf(zv[r]); ss += yv[r] * yv[r]; }
            u32x2 yw; yw.x = pk2(yv[0], yv[1]); yw.y = pk2(yv[2], yv[3]);
            *(u32x2*)(Y + (row0 + tl) * 4096 + 512 * g + 64 * hh + pc) = yw;
        }
        __syncthreads();
    }
    ss += __shfl_xor(ss, 16); ss += __shfl_xor(ss, 32);
    const float rstd = rsqrtf(ss * (1.f / 512.f) + 1e-6f);
    asm volatile("s_waitcnt vmcnt(0)" ::: "memory");
#pragma unroll 1
    for (int h2 = 0; h2 < 8; h2 += 4) {
        u32x2 v[4][4];
#pragma unroll
        for (int hh = 0; hh < 4; ++hh)
#pragma unroll
            for (int pj = 0; pj < 4; ++pj) v[hh][pj] = *(const u32x2*)(Y + (row0 + tl) * 4096 + 512 * g + 64 * (h2 + hh) + 16 * pj + 4 * (lane >> 4));
#pragma unroll
        for (int hh = 0; hh < 4; ++hh)
#pragma unroll
            for (int pj = 0; pj < 4; ++pj) {
                u32x2 w; w.x = pk2(bflo(v[hh][pj].x) * rstd, bfhi(v[hh][pj].x) * rstd); w.y = pk2(bflo(v[hh][pj].y) * rstd, bfhi(v[hh][pj].y) * rstd);
                *(u32x2*)(Y + (row0 + tl) * 4096 + 512 * g + 64 * (h2 + hh) + 16 * pj + 4 * (lane >> 4)) = w;
            }
    }
}

__device__ __forceinline__ void retF_unit(const Ctx& p, ldsp lds, int b, int h, int dvs) {
    const int tid = opaque_tid(), lane = tid & 63, wave = __builtin_amdgcn_readfirstlane(tid >> 6);
    unsigned char* ws = p.ws;
    const bf16* P = (const bf16*)(ws + WS_P); bf16* Y = (bf16*)(ws + WS_R3); float* RSS = (float*)(ws + WS_RSS);
    ldsp KI = lds; ldsp VI = lds + 67584; ldsp VW = lds + 86016; ldsp SI = lds + 104448;
    const float lg2 = log2f(1.f - exp2f(-5.f - (float)h));
    const float g128 = exp2f(128.f * lg2);
    const int tl = 16 * wave + (lane & 15);
    f32x4 acc[2][4];
#pragma unroll
    for (int i = 0; i < 2; ++i)
#pragma unroll
        for (int j = 0; j < 4; ++j) acc[i][j] = (f32x4){0.f, 0.f, 0.f, 0.f};
    const bf16* Pk = P + (size_t)b * SEQ * NAB + PRK + 256 * h + 8 * (tid & 31); const bf16* Pv = P + (size_t)b * SEQ * NAB + PRV + 512 * h + 64 * dvs + 8 * (tid & 7);
    const bf16* Pq = P + ((size_t)b * SEQ + tl) * NAB + PRQ + 256 * h + 8 * (lane >> 4);
    u32x4 rk[8], rv[2], rq[8];
#define RETF_LOAD(c_) { _Pragma("unroll") for (int i = 0; i < 8; ++i) rk[i] = *(const u32x4*)(Pk + (size_t)((c_) * 128 + ((tid + 512 * i) >> 5)) * NAB); \
        _Pragma("unroll") for (int i = 0; i < 2; ++i) rv[i] = *(const u32x4*)(Pv + (size_t)((c_) * 128 + ((tid + 512 * i) >> 3)) * NAB); }
#define RETF_LOADQ(c_) { _Pragma("unroll") for (int ks = 0; ks < 8; ++ks) rq[ks] = *(const u32x4*)(Pq + (size_t)(c_) * 128 * NAB + 32 * ks); }
    RETF_LOAD(0) RETF_LOADQ(0)
    const float qs = exp2f((float)(tl + 1) * lg2);
#pragma unroll 1
    for (int c = 0; c < 16; ++c) {
        const size_t row0 = (size_t)b * SEQ + c * 128;
#pragma unroll
        for (int i = 0; i < 8; ++i) *(LAS u32x4*)(KI + ((tid + 512 * i) >> 5) * 528 + (tid & 31) * 16) = rk[i];
#pragma unroll
        for (int i = 0; i < 2; ++i) {
            const int s = (tid + 512 * i) >> 3;
            *(LAS u32x4*)(VI + s * 144 + (tid & 7) * 16) = rv[i];
            float v[8]; unpack8(rv[i], v); const float w = exp2f((float)(127 - s) * lg2);
#pragma unroll
            for (int e = 0; e < 8; ++e) v[e] *= w;
            *(LAS u32x4*)(VW + s * 144 + (tid & 7) * 16) = pack8(v);
        }
#pragma unroll
        for (int i = 0; i < 2; ++i)
#pragma unroll
            for (int j = 0; j < 4; ++j) { u32x2 w; w.x = pk2(acc[i][j][0], acc[i][j][1]); w.y = pk2(acc[i][j][2], acc[i][j][3]);
                *(LAS u32x2*)(SI + (16 * j + (lane & 15)) * 528 + (16 * (2 * wave + i) + 4 * (lane >> 4)) * 2) = w; }
        bf16x8 QF[8];
#pragma unroll
        for (int ks = 0; ks < 8; ++ks) { float q[8]; unpack8(rq[ks], q);
#pragma unroll
            for (int e = 0; e < 8; ++e) q[e] *= qs;
            QF[ks] = __builtin_bit_cast(bf16x8, pack8(q)); }
        u32x2 gwv[4];
#pragma unroll
        for (int j = 0; j < 4; ++j) gwv[j] = *(const u32x2*)(P + (row0 + tl) * NAB + PRG + 512 * h + 64 * dvs + 16 * j + 4 * (lane >> 4));
        __syncthreads();
        if (c < 15) RETF_LOAD(c + 1)
        __builtin_amdgcn_sched_barrier(0);
        f32x4 oT[4];
#pragma unroll
        for (int j = 0; j < 4; ++j) oT[j] = (f32x4){0.f, 0.f, 0.f, 0.f};
        int lq = lane >> 4; asm volatile("" : "+v"(lq));
#pragma unroll
        for (int ks = 0; ks < 4; ++ks) if (2 * ks <= wave) {
            f32x4 sa = (f32x4){0.f, 0.f, 0.f, 0.f}, sb = (f32x4){0.f, 0.f, 0.f, 0.f};
#pragma unroll
            for (int kk = 0; kk < 8; ++kk) {
                sa = mfma16(rowfrag(KI, 528, 32 * ks, 32 * kk, lane), QF[kk], sa);
                sb = mfma16(rowfrag(KI, 528, 32 * ks + 16, 32 * kk, lane), QF[kk], sb);
            }
            f32x4 pa, pb;
#pragma unroll
            for (int r = 0; r < 4; ++r) {
                const int s0 = 32 * ks + 4 * lq + r, s1 = s0 + 16;
                pa[r] = s0 <= tl ? sa[r] * exp2f(-(float)(s0 + 1) * lg2) : 0.f;
                pb[r] = s1 <= tl ? sb[r] * exp2f(-(float)(s1 + 1) * lg2) : 0.f;
            }
            const bf16x8 Pf = packP(pa, pb);
#pragma unroll
            for (int j = 0; j < 4; ++j) oT[j] = mfma16(trfragp(VI, 144, 32 * ks, 16 * j, lane), Pf, oT[j]);
            __builtin_amdgcn_sched_barrier(0);
        }
#pragma unroll
        for (int j = 0; j < 4; ++j)
#pragma unroll
            for (int ks = 0; ks < 8; ++ks) oT[j] = mfma16(rowfrag(SI, 528, 16 * j, 32 * ks, lane), QF[ks], oT[j]);
        __builtin_amdgcn_sched_barrier(0);
        {
            float ss = 0.f;
#pragma unroll
            for (int j = 0; j < 4; ++j) {
                const int dv = 64 * dvs + 16 * j + 4 * (lane >> 4);
                const u32x2 gw = gwv[j];
                ss += (oT[j][0] * oT[j][0] + oT[j][1] * oT[j][1]) + (oT[j][2] * oT[j][2] + oT[j][3] * oT[j][3]);
                u32x2 w; w.x = pk2(siluf(bflo(gw.x)) * oT[j][0], siluf(bfhi(gw.x)) * oT[j][1]); w.y = pk2(siluf(bflo(gw.y)) * oT[j][2], siluf(bfhi(gw.y)) * oT[j][3]);
                *(u32x2*)(Y + (row0 + tl) * 4096 + 2048 + 512 * h + dv) = w;
            }
            ss += __shfl_xor(ss, 16); ss += __shfl_xor(ss, 32);
            if (lane < 16) RSS[(row0 + tl) * 32 + 8 * h + dvs] = ss;
        }
        __builtin_amdgcn_sched_barrier(0);
        if (c < 15) RETF_LOADQ(c + 1)
#pragma unroll
        for (int i = 0; i < 2; ++i)
#pragma unroll
            for (int j = 0; j < 4; ++j) acc[i][j] *= g128;
#pragma unroll
        for (int ks = 0; ks < 4; ++ks) {
            const bf16x8 A0 = trfrag(KI, 528, 32 * ks, 16 * (2 * wave), lane), A1 = trfrag(KI, 528, 32 * ks, 16 * (2 * wave + 1), lane);
#pragma unroll
            for (int j = 0; j < 4; ++j) { const bf16x8 B = trfrag(VW, 144, 32 * ks, 16 * j, lane); acc[0][j] = mfma16(A0, B, acc[0][j]); acc[1][j] = mfma16(A1, B, acc[1][j]); }
        }
        __syncthreads();
    }
#undef RETF_LOAD
#undef RETF_LOADQ
    float* so = p.out + O_RETP + ((size_t)(b * 4 + h) * 256) * 512;
#pragma unroll
    for (int i = 0; i < 2; ++i)
#pragma unroll
        for (int j = 0; j < 4; ++j)
#pragma unroll
            for (int r = 0; r < 4; ++r) so[(size_t)(16 * (2 * wave + i) + 4 * (lane >> 4) + r) * 512 + 64 * dvs + 16 * j + (lane & 15)] = acc[i][j][r];
}
__device__ __forceinline__ void retN_unit(const Ctx& p, int u) {
    const int tid = opaque_tid();
    bf16* Y = (bf16*)(p.ws + WS_R3); const float* RSS = (const float*)(p.ws + WS_RSS);
    const int cg = tid & 255, h = cg >> 6;
#pragma unroll 1
    for (int r0 = tid >> 8; r0 < 64; r0 += 16) {
        u32x4 raw[8]; float rstd[8];
#pragma unroll
        for (int q = 0; q < 8; ++q) {
            const size_t row = (size_t)u * 64 + r0 + 2 * q;
            raw[q] = *(const u32x4*)(Y + row * 4096 + 2048 + 8 * cg);
            const f32x4 s0 = *(const f32x4*)(RSS + row * 32 + 8 * h), s1 = *(const f32x4*)(RSS + row * 32 + 8 * h + 4);
            rstd[q] = rsqrtf(((s0.x + s0.y) + (s0.z + s0.w) + (s1.x + s1.y) + (s1.z + s1.w)) * (1.f / 512.f) + 1e-6f);
        }
#pragma unroll
        for (int q = 0; q < 8; ++q) {
            const size_t row = (size_t)u * 64 + r0 + 2 * q;
            float v[8]; unpack8(raw[q], v);
#pragma unroll
            for (int e = 0; e < 8; ++e) v[e] *= rstd[q];
            *(u32x4*)(Y + row * 4096 + 2048 + 8 * cg) = pack8(v);
        }
    }
}
__device__ __forceinline__ void ssdF_unit(const Ctx& p, ldsp lds, int b, int h) {
    const int tid = opaque_tid(), lane = tid & 63, wave = __builtin_amdgcn_readfirstlane(tid >> 6), g = h >> 3;
    unsigned char* ws = p.ws;
    const bf16* P = (const bf16*)(ws + WS_P); const bf16* XC = (const bf16*)(ws + WS_XC); const float* DT = (const float*)(ws + WS_DT); bf16* Y = (bf16*)(ws + WS_R3); float* SSS = (float*)(ws + WS_SSS);
    ldsp BI = lds; ldsp XD = lds + 34816; ldsp XW = lds + 53248; ldsp HI = lds + 71680;
    LAS float* CS = (LAS float*)(lds + 89088); LAS float* DTV = (LAS float*)(lds + 97280); LAS float* TOTS = (LAS float*)(lds + 105472);
    {
        const float bias = p.in(18)[h], a = -expf(p.in(19)[h]);
#pragma unroll 1
        for (int cc = wave; cc < 16; cc += 8) { const float tot = ssd_dt_scan(DT, (size_t)b * SEQ + cc * 128, h, bias, a, CS + cc * 128, DTV + cc * 128, lane); if (lane == 0) TOTS[cc] = tot; }
    }
    const float dsk0 = p.in(20)[h];
    const int pi = wave & 3, nj0 = (wave >> 2) * 4;
    const int tl = 16 * wave + (lane & 15);
    const bf16* Px = XC + (size_t)b * SEQ * 3072 + 64 * h + 8 * (tid & 7); const bf16* Pbb = XC + (size_t)b * SEQ * 3072 + 2048 + 128 * g + 8 * (tid & 15);
    const bf16* Pc = XC + ((size_t)b * SEQ + tl) * 3072 + 2560 + 128 * g + 8 * (lane >> 4);
    const bf16* Pz = P + ((size_t)b * SEQ + tl) * NAB + PZ + 64 * h + 4 * (lane >> 4);
    u32x4 rx[2], rb[4];
#define SSDF_LOAD(c_) { _Pragma("unroll") for (int i = 0; i < 2; ++i) rx[i] = *(const u32x4*)(Px + (size_t)((c_) * 128 + ((tid + 512 * i) >> 3)) * 3072); \
        _Pragma("unroll") for (int i = 0; i < 4; ++i) rb[i] = *(const u32x4*)(Pbb + (size_t)((c_) * 128 + ((tid + 512 * i) >> 4)) * 3072); }
    SSDF_LOAD(0)
    bf16x8 CFn[4]; u32x2 zwn[4];
#pragma unroll
    for (int ks = 0; ks < 4; ++ks) CFn[ks] = *(const bf16x8*)(Pc + 32 * ks);
#pragma unroll
    for (int pj = 0; pj < 4; ++pj) zwn[pj] = *(const u32x2*)(Pz + 16 * pj);
    f32x4 acc[4];
#pragma unroll
    for (int j = 0; j < 4; ++j) acc[j] = (f32x4){0.f, 0.f, 0.f, 0.f};
    __syncthreads();
#pragma unroll 1
    for (int c = 0; c < 16; ++c) {
        const size_t row0 = (size_t)b * SEQ + c * 128;
        const float tot = TOTS[c];
#pragma unroll
        for (int i = 0; i < 2; ++i) {
            const int s = (tid + 512 * i) >> 3; float o[8], ow[8]; unpack8(rx[i], o);
            const float dtv = DTV[c * 128 + s], w = __expf(tot - CS[c * 128 + s]);
#pragma unroll
            for (int e = 0; e < 8; ++e) { o[e] *= dtv; ow[e] = o[e] * w; }
            *(LAS u32x4*)(XD + s * 144 + (tid & 7) * 16) = pack8(o);
            *(LAS u32x4*)(XW + s * 144 + (tid & 7) * 16) = pack8(ow);
        }
#pragma unroll
        for (int i = 0; i < 4; ++i) *(LAS u32x4*)(BI + ((tid + 512 * i) >> 4) * 272 + (tid & 15) * 16) = rb[i];
#pragma unroll
        for (int j = 0; j < 4; ++j) { u32x2 w; w.x = pk2(acc[j][0], acc[j][1]); w.y = pk2(acc[j][2], acc[j][3]);
            *(LAS u32x2*)(HI + (16 * pi + (lane & 15)) * 272 + (16 * (nj0 + j) + 4 * (lane >> 4)) * 2) = w; }
        bf16x8 CF[4]; u32x2 zw[4];
#pragma unroll
        for (int ks = 0; ks < 4; ++ks) CF[ks] = CFn[ks];
#pragma unroll
        for (int pj = 0; pj < 4; ++pj) zw[pj] = zwn[pj];
        __syncthreads();
        if (c < 15) { SSDF_LOAD(c + 1)
#pragma unroll
            for (int ks = 0; ks < 4; ++ks) CFn[ks] = *(const bf16x8*)(Pc + (size_t)(c + 1) * 128 * 3072 + 32 * ks);
#pragma unroll
            for (int pj = 0; pj < 4; ++pj) zwn[pj] = *(const u32x2*)(Pz + (size_t)(c + 1) * 128 * NAB + 16 * pj); }
        int lq = lane >> 4; asm volatile("" : "+v"(lq));
        const float cst = CS[c * 128 + tl];
        f32x4 yT[4], yI[4];
#pragma unroll
        for (int pj = 0; pj < 4; ++pj) { yT[pj] = (f32x4){0.f, 0.f, 0.f, 0.f}; yI[pj] = (f32x4){0.f, 0.f, 0.f, 0.f}; }
#pragma unroll
        for (int ks = 0; ks < 4; ++ks) if (2 * ks <= wave) {
            f32x4 sa = (f32x4){0.f, 0.f, 0.f, 0.f}, sb = (f32x4){0.f, 0.f, 0.f, 0.f};
#pragma unroll
            for (int kk = 0; kk < 4; ++kk) {
                sa = mfma16(rowfrag(BI, 272, 32 * ks, 32 * kk, lane), CF[kk], sa);
                sb = mfma16(rowfrag(BI, 272, 32 * ks + 16, 32 * kk, lane), CF[kk], sb);
            }
            f32x4 pa, pb;
#pragma unroll
            for (int r = 0; r < 4; ++r) {
                const int s0 = 32 * ks + 4 * lq + r, s1 = s0 + 16;
                pa[r] = s0 <= tl ? sa[r] * __expf(cst - CS[c * 128 + s0]) : 0.f;
                pb[r] = s1 <= tl ? sb[r] * __expf(cst - CS[c * 128 + s1]) : 0.f;
            }
            const bf16x8 Pf = packP(pa, pb);
#pragma unroll
            for (int pj = 0; pj < 4; ++pj) yT[pj] = mfma16(trfragp(XD, 144, 32 * ks, 16 * pj, lane), Pf, yT[pj]);
        }
#pragma unroll
        for (int ks = 0; ks < 4; ++ks)
#pragma unroll
            for (int pj = 0; pj < 4; ++pj) yI[pj] = mfma16(rowfrag(HI, 272, 16 * pj, 32 * ks, lane), CF[ks], yI[pj]);
        {
            const float ecs = __expf(cst), dsk = dsk0 / DTV[c * 128 + tl];
            float ss = 0.f;
#pragma unroll
            for (int pj = 0; pj < 4; ++pj) {
                const int pc = 16 * pj + 4 * lq;
                const u32x2 xw = *(const LAS u32x2*)(XD + tl * 144 + pc * 2);
                const float xv[4] = {bflo(xw.x), bfhi(xw.x), bflo(xw.y), bfhi(xw.y)}, zv[4] = {bflo(zw[pj].x), bfhi(zw[pj].x), bflo(zw[pj].y), bfhi(zw[pj].y)};
                float yv[4];
#pragma unroll
                for (int r = 0; r < 4; ++r) { yv[r] = (yT[pj][r] + ecs * yI[pj][r] + dsk * xv[r]) * siluf(zv[r]); ss += yv[r] * yv[r]; }
                u32x2 yw; yw.x = pk2(yv[0], yv[1]); yw.y = pk2(yv[2], yv[3]);
                *(u32x2*)(Y + (row0 + tl) * 4096 + 64 * h + pc) = yw;
            }
            ss += __shfl_xor(ss, 16); ss += __shfl_xor(ss, 32);
            if (lane < 16) SSS[(row0 + tl) * 32 + h] = ss;
        }
        const float dec = __expf(tot);
#pragma unroll
        for (int j = 0; j < 4; ++j) acc[j] *= dec;
#pragma unroll
        for (int ks = 0; ks < 4; ++ks) {
            const bf16x8 Xf = trfrag(XW, 144, 32 * ks, 16 * pi, lane);
#pragma unroll
            for (int j = 0; j < 4; ++j) acc[j] = mfma16(trfrag(BI, 272, 32 * ks, 16 * (nj0 + j), lane), Xf, acc[j]);
        }
        __syncthreads();
    }
#undef SSDF_LOAD
    float* so = p.out + O_SSMP + ((size_t)(b * 32 + h) * 64) * 128;
#pragma unroll
    for (int j = 0; j < 4; ++j) *(f32x4*)(so + (16 * pi + (lane & 15)) * 128 + 16 * (nj0 + j) + 4 * (lane >> 4)) = acc[j];
}
__device__ __forceinline__ void norm_unit(const Ctx& p, int u) {
    const int tid = opaque_tid();
    bf16* Y = (bf16*)(p.ws + WS_R3); const float* RSS = (const float*)(p.ws + WS_RSS); const float* SSS = (const float*)(p.ws + WS_SSS);
    const int cg = tid;
    const float* stat = (cg < 256 ? SSS : RSS) + 8 * ((cg >> 6) & 3);
#pragma unroll 4
    for (int r = 0; r < 64; ++r) {
        const size_t row = (size_t)u * 64 + r;
        const f32x4 s0 = *(const f32x4*)(stat + row * 32), s1 = *(const f32x4*)(stat + row * 32 + 4);
        const float rstd = rsqrtf(((s0.x + s0.y) + (s0.z + s0.w) + (s1.x + s1.y) + (s1.z + s1.w)) * (1.f / 512.f) + 1e-6f);
        u32x4* yp = (u32x4*)(Y + row * 4096 + 8 * cg);
        float v[8]; unpack8(*yp, v);
#pragma unroll
        for (int e = 0; e < 8; ++e) v[e] *= rstd;
        *yp = pack8(v);
    }
}
constexpr float KSC = 0.08838834764831845f;
constexpr int CCR = 272;

__device__ __forceinline__ float mlstm_gates(const float* GT, size_t row0, int h, float ib, float fb, int lane, float& b0, float& b1, float& g0, float& g1) {
    const int s0 = 2 * lane;
    const float i0 = GT[(row0 + s0) * 8 + h] + ib, i1 = GT[(row0 + s0 + 1) * 8 + h] + ib;
    const float l0 = logsigf(GT[(row0 + s0) * 8 + 4 + h] + fb), l1 = logsigf(GT[(row0 + s0 + 1) * 8 + 4 + h] + fb);
    float v = l0 + l1;
#pragma unroll
    for (int o = 1; o < 64; o <<= 1) { const float t = __shfl_up(v, o); if (lane >= o) v += t; }
    b0 = v - l1; b1 = v; g0 = i0 - b0; g1 = i1 - b1;
    return __shfl(v, 63);
}

__device__ __forceinline__ void mlA_unit(const Ctx& p, ldsp lds, int b, int h, int dvs) {
    const int tid = opaque_tid(), lane = tid & 63, wave = __builtin_amdgcn_readfirstlane(tid >> 6);
    unsigned char* ws = p.ws;
    const bf16* P2 = (const bf16*)(ws + WS_P); const float* GT = (const float*)(ws + WS_DT); bf16* CC = (bf16*)(ws + WS_SC); float* MCH = (float*)(ws + WS_MCH);
    ldsp KW = lds; ldsp VI = lds + 34816; LAS float* GV = (LAS float*)(lds + 49152); LAS float* BT = GV + 2048; LAS float* GM = BT + 16; LAS float* MS = GM + 16; LAS float* DP = MS + 32;
    {
        const float ib = p.in(24)[h], fb = p.in(25)[h];
#pragma unroll 1
        for (int cc = wave; cc < 16; cc += 8) {
            float b0, b1, g0, g1; const float btot = mlstm_gates(GT, (size_t)b * SEQ + cc * 128, h, ib, fb, lane, b0, b1, g0, g1);
            const float gmax = wave_max(fmaxf(g0, g1));
            GV[cc * 128 + 2 * lane] = g0; GV[cc * 128 + 2 * lane + 1] = g1;
            if (lane == 0) { BT[cc] = btot; GM[cc] = gmax; }
        }
    }
    const bf16* Pk = P2 + (size_t)b * SEQ * NC + CK + 128 * h + 8 * (tid & 15); const bf16* Pv = P2 + (size_t)b * SEQ * NC + CV + 256 * h + 32 * dvs + 8 * (tid & 3);
    const int vcg = tid & 7;
    u32x4 rk[4], rv[2];
#pragma unroll
    for (int i = 0; i < 4; ++i) rk[i] = *(const u32x4*)(Pk + (size_t)((tid + 512 * i) >> 4) * NC);
#pragma unroll
    for (int i = 0; i < 2; ++i) rv[i] = *(const u32x4*)(Pv + (size_t)((tid + 512 * i) >> 3) * NC);
    __syncthreads();
    if (tid == 0) {
        float m = 0.f;
        for (int cc = 0; cc < 16; ++cc) { const float mn = BT[cc] + fmaxf(m, GM[cc]); MS[cc] = m; DP[cc] = __expf(BT[cc] + m - mn); if (dvs == 0) MCH[(b * 4 + h) * 16 + cc] = m; m = mn; }
        MS[16] = m;
    }
    f32x4 acc[3];
#pragma unroll
    for (int j = 0; j < 3; ++j) acc[j] = (f32x4){0.f, 0.f, 0.f, 0.f};
    __syncthreads();
#pragma unroll 1
    for (int c = 0; c < 16; ++c) {
        const float bm = BT[c] - MS[c + 1];
#pragma unroll
        for (int i = 0; i < 4; ++i) {
            const int s = (tid + 512 * i) >> 4; float k[8]; unpack8(rk[i], k);
            const float w = KSC * __expf(GV[c * 128 + s] + bm);
#pragma unroll
            for (int e = 0; e < 8; ++e) k[e] *= w;
            *(LAS u32x4*)(KW + s * 272 + (tid & 15) * 16) = pack8(k);
        }
#pragma unroll
        for (int i = 0; i < 2; ++i) {
            const int s = (tid + 512 * i) >> 3;
            unsigned zz = 0u; asm volatile("" : "+v"(zz));
            if (vcg < 4) *(LAS u32x4*)(VI + s * 112 + vcg * 16) = rv[i];
            else if (vcg == 4) *(LAS u32x4*)(VI + s * 112 + 64) = (u32x4){zz | 0x3F80u, zz, zz, zz};
            else if (vcg == 5) *(LAS u32x4*)(VI + s * 112 + 80) = (u32x4){zz, zz, zz, zz};
        }
        __syncthreads();
        if (c < 15) {
#pragma unroll
            for (int i = 0; i < 4; ++i) rk[i] = *(const u32x4*)(Pk + (size_t)((c + 1) * 128 + ((tid + 512 * i) >> 4)) * NC);
#pragma unroll
            for (int i = 0; i < 2; ++i) rv[i] = *(const u32x4*)(Pv + (size_t)((c + 1) * 128 + ((tid + 512 * i) >> 3)) * NC);
        }
        {
            bf16* cc = CC + (((size_t)(b * 4 + h) * 16 + c) * CCR) * 128;
            const int dk0 = 16 * wave + 4 * (lane >> 4);
#pragma unroll
            for (int j = 0; j < 2; ++j) { u32x2 w; w.x = pk2(acc[j][0], acc[j][1]); w.y = pk2(acc[j][2], acc[j][3]); *(u32x2*)(cc + (size_t)(32 * dvs + 16 * j + (lane & 15)) * 128 + dk0) = w; }
            if (dvs == 0) { u32x2 w; w.x = pk2(acc[2][0], acc[2][1]); w.y = pk2(acc[2][2], acc[2][3]); *(u32x2*)(cc + (size_t)(256 + (lane & 15)) * 128 + dk0) = w; }
        }
        const float dp = DP[c];
#pragma unroll
        for (int j = 0; j < 3; ++j) acc[j] *= dp;
#pragma unroll
        for (int ks = 0; ks < 4; ++ks) {
            const bf16x8 A = trfrag(KW, 272, 32 * ks, 16 * wave, lane);
#pragma unroll
            for (int j = 0; j < 3; ++j) acc[j] = mfma16(A, trfrag(VI, 112, 32 * ks, 16 * j, lane), acc[j]);
        }
        __syncthreads();
    }
    float* co = p.out + O_MCP + ((size_t)(b * 4 + h) * 128) * 256;
#pragma unroll
    for (int j = 0; j < 2; ++j)
#pragma unroll
        for (int r = 0; r < 4; ++r) co[(size_t)(16 * wave + 4 * (lane >> 4) + r) * 256 + 32 * dvs + 16 * j + (lane & 15)] = acc[j][r];
    if (dvs == 0) {
        if ((lane & 15) == 0) {
#pragma unroll
            for (int r = 0; r < 4; ++r) p.out[O_MNP + (size_t)(b * 4 + h) * 128 + 16 * wave + 4 * (lane >> 4) + r] = acc[2][r];
        }
        if (tid == 0) p.out[O_MMP + b * 4 + h] = MS[16];
    }
    __syncthreads();
}

__device__ __forceinline__ void mlB_unit(const Ctx& p, ldsp lds, int b, int h, int c) {
    const int tid = opaque_tid(), lane = tid & 63, wave = __builtin_amdgcn_readfirstlane(tid >> 6);
    unsigned char* ws = p.ws;
    const bf16* P2 = (const bf16*)(ws + WS_P); const float* GT = (const float*)(ws + WS_DT); const bf16* CC = (const bf16*)(ws + WS_SC); const float* MCH = (const float*)(ws + WS_MCH);
    bf16* Y2 = (bf16*)(ws + WS_R3);
    ldsp KI = lds; ldsp VI = lds + 34816; LAS float* GB = (LAS float*)(lds + 102400); LAS float* GG = GB + 128; LAS float* MT = GG + 128;
    const size_t row0 = (size_t)b * SEQ + c * 128;
    const float mc = MCH[(b * 4 + h) * 16 + c];
    if (wave == 0) {
        float b0, b1, g0, g1; (void)mlstm_gates(GT, row0, h, p.in(24)[h], p.in(25)[h], lane, b0, b1, g0, g1);
        float v = fmaxf(g0, g1);
#pragma unroll
        for (int o = 1; o < 64; o <<= 1) { const float t = __shfl_up(v, o); if (lane >= o) v = fmaxf(v, t); }
        float prev = __shfl_up(v, 1); if (lane == 0) prev = -3.0e38f;
        const float M0 = fmaxf(prev, g0), M1 = fmaxf(M0, g1);
        GB[2 * lane] = b0; GB[2 * lane + 1] = b1; GG[2 * lane] = g0; GG[2 * lane + 1] = g1;
        MT[2 * lane] = b0 + fmaxf(mc, M0); MT[2 * lane + 1] = b1 + fmaxf(mc, M1);
    }
#pragma unroll
    for (int i = 0; i < 4; ++i) {
        const int id = tid + 512 * i, s = id >> 4, cg = id & 15; float k[8];
        unpack8(*(const u32x4*)(P2 + (row0 + s) * NC + CK + 128 * h + 8 * cg), k);
#pragma unroll
        for (int e = 0; e < 8; ++e) k[e] *= KSC;
        *(LAS u32x4*)(KI + s * 272 + cg * 16) = pack8(k);
    }
#pragma unroll
    for (int i = 0; i < 8; ++i) {
        const int id = tid + 512 * i, s = id >> 5, cg = id & 31;
        *(LAS u32x4*)(VI + s * 528 + cg * 16) = *(const u32x4*)(P2 + (row0 + s) * NC + CV + 256 * h + 8 * cg);
    }
    __syncthreads();
    const int tl = 16 * wave + (lane & 15);
    const float bt = GB[tl], mt = MT[tl], inter = __expf(bt + mc - mt);
    bf16x8 QF[4], QF2[4];
#pragma unroll
    for (int ks = 0; ks < 4; ++ks) {
        QF[ks] = gfrag(P2 + CQ + 128 * h, NC, (int)row0 + 16 * wave, 32 * ks, lane);
        float q[8]; unpack8(__builtin_bit_cast(u32x4, QF[ks]), q);
#pragma unroll
        for (int e = 0; e < 8; ++e) q[e] *= inter;
        QF2[ks] = __builtin_bit_cast(bf16x8, pack8(q));
    }
    f32x4 ST[8];
#pragma unroll
    for (int sj = 0; sj < 8; ++sj) ST[sj] = (f32x4){0.f, 0.f, 0.f, 0.f};
#pragma unroll
    for (int sj = 0; sj < 8; ++sj) if (sj <= wave) {
#pragma unroll
        for (int ks = 0; ks < 4; ++ks) ST[sj] = mfma16(rowfrag(KI, 272, 16 * sj, 32 * ks, lane), QF[ks], ST[sj]);
    }
    bf16x8 PF[4]; float asum = 0.f;
#pragma unroll
    for (int ks = 0; ks < 4; ++ks) {
        f32x4 pa, pb;
#pragma unroll
        for (int r = 0; r < 4; ++r) {
            const int s0 = 32 * ks + 4 * (lane >> 4) + r, s1 = s0 + 16;
            pa[r] = s0 <= tl ? ST[2 * ks][r] * __expf(GG[s0] + bt - mt) : 0.f;
            pb[r] = s1 <= tl ? ST[2 * ks + 1][r] * __expf(GG[s1] + bt - mt) : 0.f;
            asum += pa[r] + pb[r];
        }
        PF[ks] = packP(pa, pb);
    }
    asum += __shfl_xor(asum, 16); asum += __shfl_xor(asum, 32);
    const bf16* cc = CC + (((size_t)(b * 4 + h) * 16 + c) * CCR) * 128;
    f32x4 nT[16];
    bf16x8 CFr[3][4];
#pragma unroll
    for (int ks = 0; ks < 4; ++ks) { CFr[0][ks] = gfrag(cc, 128, 0, 32 * ks, lane); CFr[1][ks] = gfrag(cc, 128, 16, 32 * ks, lane); }
#pragma unroll
    for (int dj = 0; dj < 16; ++dj) {
#pragma unroll
        for (int ks = 0; ks < 4; ++ks) CFr[(dj + 2) % 3][ks] = gfrag(cc, 128, 16 * (dj + 2), 32 * ks, lane);
        nT[dj] = (f32x4){0.f, 0.f, 0.f, 0.f};
#pragma unroll
        for (int ks = 0; ks < 4; ++ks) if (2 * ks <= wave) nT[dj] = mfma16(trfragp(VI, 528, 32 * ks, 16 * dj, lane), PF[ks], nT[dj]);
#pragma unroll
        for (int ks = 0; ks < 4; ++ks) nT[dj] = mfma16(CFr[dj % 3][ks], QF2[ks], nT[dj]);
    }
    f32x4 dn = (f32x4){0.f, 0.f, 0.f, 0.f};
#pragma unroll
    for (int ks = 0; ks < 4; ++ks) dn = mfma16(CFr[16 % 3][ks], QF2[ks], dn);
    const float qn = __shfl(dn[0], lane & 15);
    const float den = asum + qn;
    const float hdiv = 1.f / fmaxf(fabsf(den), __expf(-mt));
    float ss = 0.f;
#pragma unroll
    for (int dj = 0; dj < 16; ++dj)
#pragma unroll
        for (int r = 0; r < 4; ++r) { nT[dj][r] *= hdiv; ss += nT[dj][r] * nT[dj][r]; }
    ss += __shfl_xor(ss, 16); ss += __shfl_xor(ss, 32);
    const float rstd = rsqrtf(ss * (1.f / 256.f) + 1e-6f);
    u32x2 owv[16];
#pragma unroll
    for (int dj = 0; dj < 16; ++dj) owv[dj] = *(const u32x2*)(P2 + (row0 + tl) * NC + CO + 256 * h + 16 * dj + 4 * (lane >> 4));
#pragma unroll
    for (int dj = 0; dj < 16; ++dj) {
        const int dv = 16 * dj + 4 * (lane >> 4);
        const u32x2 ow = owv[dj];
        u32x2 w; w.x = pk2(sigmf(bflo(ow.x)) * nT[dj][0] * rstd, sigmf(bfhi(ow.x)) * nT[dj][1] * rstd);
        w.y = pk2(sigmf(bflo(ow.y)) * nT[dj][2] * rstd, sigmf(bfhi(ow.y)) * nT[dj][3] * rstd);
        *(u32x2*)(Y2 + (row0 + tl) * 1024 + 256 * h + dv) = w;
    }
    __syncthreads();
}

__device__ __forceinline__ void mlS_unit(const Ctx& p, ldsp lds, int b, int h) {
    const int tid = opaque_tid(), lane = tid & 63, wave = __builtin_amdgcn_readfirstlane(tid >> 6);
    unsigned char* ws = p.ws;
    const bf16* P2 = (const bf16*)(ws + WS_P); const float* GT = (const float*)(ws + WS_DT); bf16* Y2 = (bf16*)(ws + WS_R3);
    const size_t row = NP + b;
    LAS float* QS = (LAS float*)lds; LAS float* KS = QS + 128; LAS float* VS = KS + 128; LAS float* RD = VS + 256; LAS float* RED = RD + 2048; LAS float* DEN = RED + 8;
    const int dvq = tid & 63, dkg = tid >> 6;
    const size_t sb = ((size_t)(b * 4 + h) * 128) * 256 + 4 * dvq;
    const float* si = p.in(7) + sb; float* so = p.out + O_MCS + sb;
    f32x4 s[16];
#pragma unroll
    for (int i = 0; i < 16; ++i) s[i] = ldnt4(si + (size_t)(dkg + 8 * i) * 256);
    const float ig = GT[row * 8 + h] + p.in(24)[h], lf = logsigf(GT[row * 8 + 4 + h] + p.in(25)[h]);
    const float m0 = p.in(9)[b * 4 + h];
    const float mn = fmaxf(lf + m0, ig), fp = expf(lf + m0 - mn), ip = expf(ig - mn);
    float dpart = 0.f;
    if (tid < 128) {
        const float q = bf2f(P2[row * NC + CQ + 128 * h + tid]), k = bf2f(P2[row * NC + CK + 128 * h + tid]) * KSC;
        const float nn = fp * p.in(8)[(size_t)(b * 4 + h) * 128 + tid] + ip * k;
        p.out[O_MNS + (size_t)(b * 4 + h) * 128 + tid] = nn;
        QS[tid] = q; KS[tid] = k; dpart = q * nn;
    }
    if (tid < 256) VS[tid] = bf2f(P2[row * NC + CV + 256 * h + tid]);
    if (tid == 0) p.out[O_MMS + b * 4 + h] = mn;
    const float den = block_sum8(dpart, RED, lane, wave);
    const f32x4 v4 = *(const LAS f32x4*)(VS + 4 * dvq);
    f32x4 n4 = (f32x4){0.f, 0.f, 0.f, 0.f};
#pragma unroll
    for (int i = 0; i < 16; ++i) {
        const int dk = dkg + 8 * i;
        const f32x4 cn = fp * s[i] + (ip * KS[dk]) * v4;
        stnt4(so + (size_t)dk * 256, cn);
        n4 += QS[dk] * cn;
    }
    *(LAS f32x4*)(RD + dkg * 256 + 4 * dvq) = n4;
    __syncthreads();
    float hv = 0.f;
    if (tid < 256) { float num = 0.f;
#pragma unroll
        for (int j = 0; j < 8; ++j) num += RD[j * 256 + tid];
        hv = num / fmaxf(fabsf(den), expf(-mn)); }
    const float tot = block_sum8(hv * hv, RED, lane, wave);
    if (tid < 256) { const float o = bf2f(P2[row * NC + CO + 256 * h + tid]);
        Y2[row * 1024 + 256 * h + tid] = (bf16)(pk2(sigmf(o) * hv * rsqrtf(tot * (1.f / 256.f) + 1e-6f), 0.f) & 0xffffu); }
    __syncthreads();
}

__device__ __forceinline__ void xaP_unit(const Ctx& p, ldsp lds, int layer, int b, int h, int qt) {
    const int tid = opaque_tid(), lane = tid & 63, wave = __builtin_amdgcn_readfirstlane(tid >> 6);
    unsigned char* ws = p.ws;
    const bf16* Q = (const bf16*)(ws + WS_R3); bf16* O = (bf16*)(ws + WS_R3 + (size_t)MP * 1024 * 2);
    const bf16* KB = (const bf16*)(ws + WS_KB) + (size_t)layer * 2048 * 1024 + (size_t)b * 256 * 1024 + 256 * h;
    const bf16* VB = (const bf16*)(ws + WS_VB) + (size_t)layer * 2048 * 1024 + (size_t)b * 256 * 1024 + 256 * h;
    const int row0 = b * SEQ + 128 * qt + 16 * wave;
    const size_t toff = (size_t)(tid >> 5) * 1024 + 8 * (tid & 31);
    u32x4 rq[4];
#pragma unroll
    for (int i = 0; i < 4; ++i) rq[i] = *(const u32x4*)(KB + toff + (size_t)i * 16 * 1024);
    bf16x8 QF[8];
#pragma unroll
    for (int ks = 0; ks < 8; ++ks) QF[ks] = gfrag(Q + 256 * h, 1024, row0, 32 * ks, lane);
    f32x4 ST[16];
    bf16x8 PF[8];
    f32x4 OT[16];
#pragma unroll
    for (int dj = 0; dj < 16; ++dj) OT[dj] = (f32x4){0.f, 0.f, 0.f, 0.f};
    float sum = 0.f;
#pragma unroll
    for (int q = 0; q < 8; ++q) {
        ldsp KQ = lds + (q & 1) * 33792;
#pragma unroll
        for (int i = 0; i < 4; ++i) *(LAS u32x4*)(KQ + ((tid >> 5) + 16 * i) * 528 + (tid & 31) * 16) = rq[i];
        __syncthreads();
        if (q < 7) {
            const bf16* src = (q + 1 < 4) ? KB + (size_t)(64 * (q + 1)) * 1024 : VB + (size_t)(64 * (q + 1 - 4)) * 1024;
#pragma unroll
            for (int i = 0; i < 4; ++i) rq[i] = *(const u32x4*)(src + toff + (size_t)i * 16 * 1024);
        }
        if (q < 4) {
#pragma unroll
            for (int j = 0; j < 4; ++j) {
                ST[4 * q + j] = (f32x4){0.f, 0.f, 0.f, 0.f};
#pragma unroll
                for (int ks = 0; ks < 8; ++ks) ST[4 * q + j] = mfma16(rowfrag(KQ, 528, 16 * j, 32 * ks, lane), QF[ks], ST[4 * q + j]);
            }
            if (q == 3) {
                float mx = -3.0e38f;
#pragma unroll
                for (int mj = 0; mj < 16; ++mj)
#pragma unroll
                    for (int r = 0; r < 4; ++r) mx = fmaxf(mx, ST[mj][r]);
                mx = fmaxf(mx, __shfl_xor(mx, 16)); mx = fmaxf(mx, __shfl_xor(mx, 32));
#pragma unroll
                for (int mj = 0; mj < 16; ++mj)
#pragma unroll
                    for (int r = 0; r < 4; ++r) { const float e = __expf((ST[mj][r] - mx) * 0.0625f); ST[mj][r] = e; sum += e; }
                sum += __shfl_xor(sum, 16); sum += __shfl_xor(sum, 32);
#pragma unroll
                for (int k2 = 0; k2 < 8; ++k2) PF[k2] = packP(ST[2 * k2], ST[2 * k2 + 1]);
            }
        } else {
            const int qv = q - 4;
#pragma unroll
            for (int dj = 0; dj < 16; ++dj)
#pragma unroll
                for (int kk = 0; kk < 2; ++kk) OT[dj] = mfma16(trfragp(KQ, 528, 32 * kk, 16 * dj, lane), PF[2 * qv + kk], OT[dj]);
        }
    }
    const float inv = 1.f / sum;
    const int row = row0 + (lane & 15);
#pragma unroll
    for (int dj = 0; dj < 16; ++dj) { u32x2 w; w.x = pk2(OT[dj][0] * inv, OT[dj][1] * inv); w.y = pk2(OT[dj][2] * inv, OT[dj][3] * inv);
        *(u32x2*)(O + (size_t)row * 1024 + 256 * h + 16 * dj + 4 * (lane >> 4)) = w; }
    __syncthreads();
}
__device__ __forceinline__ void xaS_unit(const Ctx& p, ldsp lds, int layer, int b, int h) {
    const int tid = opaque_tid(), lane = tid & 63, wave = __builtin_amdgcn_readfirstlane(tid >> 6);
    unsigned char* ws = p.ws;
    const bf16* Q = (const bf16*)(ws + WS_R3); bf16* O = (bf16*)(ws + WS_R3 + (size_t)MP * 1024 * 2);
    const size_t row = NP + b;
    const float* Kc = p.in(2) + ((size_t)(layer * 128 + b) * 256) * 1024 + 256 * h; const float* Vc = p.in(3) + ((size_t)(layer * 128 + b) * 256) * 1024 + 256 * h;
    LAS float* QS = (LAS float*)lds; LAS float* SC = QS + 256; LAS float* RD = SC + 256; LAS float* RED = RD + 2048;
    if (tid < 256) QS[tid] = bf2f(Q[row * 1024 + 256 * h + tid]);
    __syncthreads();
    const f32x4 q4 = *(const LAS f32x4*)(QS + 4 * lane);
#pragma unroll 1
    for (int i0 = 0; i0 < 32; i0 += 16) {
        f32x4 kr[16];
#pragma unroll
        for (int i = 0; i < 16; ++i) kr[i] = ldnt4(Kc + (size_t)(wave + 8 * (i0 + i)) * 1024 + 4 * lane);
#pragma unroll
        for (int i = 0; i < 16; ++i) {
            const float s = wave_sum((kr[i].x * q4.x + kr[i].y * q4.y) + (kr[i].z * q4.z + kr[i].w * q4.w));
            if (lane == 0) SC[wave + 8 * (i0 + i)] = s * 0.0625f;
        }
    }
    f32x4 vpre[32];
#pragma unroll
    for (int i = 0; i < 32; ++i) vpre[i] = ldnt4(Vc + (size_t)(wave + 8 * i) * 1024 + 4 * lane);
    __syncthreads();
    const float sv = tid < 256 ? SC[tid] : -3.0e38f;
    float mx = wave_max(sv);
    __syncthreads();
    if (lane == 0) RED[wave] = mx;
    __syncthreads();
    mx = fmaxf(fmaxf(fmaxf(RED[0], RED[1]), fmaxf(RED[2], RED[3])), fmaxf(fmaxf(RED[4], RED[5]), fmaxf(RED[6], RED[7])));
    const float e = tid < 256 ? __expf(sv - mx) : 0.f;
    const float tot = block_sum8(e, RED, lane, wave);
    if (tid < 256) SC[tid] = e / tot;
    __syncthreads();
    f32x4 o4 = (f32x4){0.f, 0.f, 0.f, 0.f};
#pragma unroll
    for (int i = 0; i < 32; ++i) o4 += SC[wave + 8 * i] * vpre[i];
    *(LAS f32x4*)(RD + wave * 256 + 4 * lane) = o4;
    __syncthreads();
    if (tid < 256) { float o = 0.f;
#pragma unroll
        for (int j = 0; j < 8; ++j) o += RD[j * 256 + tid];
        O[row * 1024 + 256 * h + tid] = (bf16)(pk2(o, 0.f) & 0xffffu); }
    __syncthreads();
}

__device__ __forceinline__ void xaS2_unit(const Ctx& p, ldsp lds, int layer, int b, int hp) {
    const int tid = opaque_tid(), lane = tid & 63, wave = __builtin_amdgcn_readfirstlane(tid >> 6);
    unsigned char* ws = p.ws;
    const bf16* Q = (const bf16*)(ws + WS_R3); bf16* O = (bf16*)(ws + WS_R3 + (size_t)MP * 1024 * 2);
    const size_t row = NP + b;
    const float* Kc = p.in(2) + ((size_t)(layer * 128 + b) * 256) * 1024 + 512 * hp + 4 * lane; const float* Vc = p.in(3) + ((size_t)(layer * 128 + b) * 256) * 1024 + 512 * hp + 4 * lane;
    LAS float* QS = (LAS float*)lds; LAS float* SC = QS + 512; LAS float* RD = SC + 512; LAS float* RED = RD + 4096;
    QS[tid] = bf2f(Q[row * 1024 + 512 * hp + tid]);
    __syncthreads();
    const f32x4 qa = *(const LAS f32x4*)(QS + 4 * lane), qb = *(const LAS f32x4*)(QS + 256 + 4 * lane);
#pragma unroll 1
    for (int i0 = 0; i0 < 32; i0 += 8) {
        f32x4 ka[8], kb[8];
#pragma unroll
        for (int i = 0; i < 8; ++i) { const float* kr = Kc + (size_t)(wave + 8 * (i0 + i)) * 1024; ka[i] = ldnt4(kr); kb[i] = ldnt4(kr + 256); }
#pragma unroll
        for (int i = 0; i < 8; ++i) {
            const float sa = wave_sum((ka[i].x * qa.x + ka[i].y * qa.y) + (ka[i].z * qa.z + ka[i].w * qa.w));
            const float sb = wave_sum((kb[i].x * qb.x + kb[i].y * qb.y) + (kb[i].z * qb.z + kb[i].w * qb.w));
            if (lane == 0) { SC[wave + 8 * (i0 + i)] = sa * 0.0625f; SC[256 + wave + 8 * (i0 + i)] = sb * 0.0625f; }
        }
    }
    f32x4 va[16], vb[16];
#pragma unroll
    for (int i = 0; i < 16; ++i) { const float* vr = Vc + (size_t)(wave + 8 * i) * 1024; va[i] = ldnt4(vr); vb[i] = ldnt4(vr + 256); }
    __syncthreads();
    const float sv = SC[tid];
    float mx = wave_max(sv);
    __syncthreads();
    if (lane == 0) RED[wave] = mx;
    __syncthreads();
    { const int w0 = wave & 4; mx = fmaxf(fmaxf(RED[w0], RED[w0 + 1]), fmaxf(RED[w0 + 2], RED[w0 + 3])); }
    const float e = __expf(sv - mx);
    float es = wave_sum(e);
    __syncthreads();
    if (lane == 0) RED[wave] = es;
    __syncthreads();
    { const int w0 = wave & 4; es = (RED[w0] + RED[w0 + 1]) + (RED[w0 + 2] + RED[w0 + 3]); }
    SC[tid] = e * __builtin_amdgcn_rcpf(es);
    __syncthreads();
    f32x4 oa = (f32x4){0.f, 0.f, 0.f, 0.f}, ob = (f32x4){0.f, 0.f, 0.f, 0.f};
#pragma unroll
    for (int i = 0; i < 16; ++i) { oa += SC[wave + 8 * i] * va[i]; ob += SC[256 + wave + 8 * i] * vb[i]; }
#pragma unroll 1
    for (int i0 = 16; i0 < 32; i0 += 8) {
#pragma unroll
        for (int i = 0; i < 8; ++i) { const float* vr = Vc + (size_t)(wave + 8 * (i0 + i)) * 1024; va[i] = ldnt4(vr); vb[i] = ldnt4(vr + 256); }
#pragma unroll
        for (int i = 0; i < 8; ++i) { oa += SC[wave + 8 * (i0 + i)] * va[i]; ob += SC[256 + wave + 8 * (i0 + i)] * vb[i]; }
    }
    *(LAS f32x4*)(RD + wave * 512 + 4 * lane) = oa; *(LAS f32x4*)(RD + wave * 512 + 256 + 4 * lane) = ob;
    __syncthreads();
    { float o = 0.f;
#pragma unroll
      for (int j = 0; j < 8; ++j) o += RD[j * 512 + tid];
      O[row * 1024 + 512 * hp + tid] = (bf16)(pk2(o, 0.f) & 0xffffu); }
    __syncthreads();
}

__device__ __forceinline__ void final_norm(const Ctx& p, int vcu, int G) {
    const int tid = opaque_tid(), lane = tid & 63, wave = tid >> 6;
    const bf16* XB = (const bf16*)(p.ws + WS_XB); const float* gn = p.in(36);
    const int NGW = G * 8;
    f32x4 gv[2][2];
#pragma unroll
    for (int j = 0; j < 2; ++j) { gv[j][0] = *(const f32x4*)(gn + 512 * j + 8 * lane); gv[j][1] = *(const f32x4*)(gn + 512 * j + 8 * lane + 4); }
    for (int row = vcu * 8 + wave; row < MR; row += 2 * NGW) {
        u32x4 raw[2][2];
#pragma unroll
        for (int q = 0; q < 2; ++q) { const int r = row + q * NGW < MR ? row + q * NGW : row; const u32x4* src = (const u32x4*)(XB + (size_t)r * D) + lane; raw[q][0] = src[0]; raw[q][1] = src[64]; }
#pragma unroll
        for (int q = 0; q < 2; ++q) if (row + q * NGW < MR) {
            float v[2][8]; float ss = 0.f;
#pragma unroll
            for (int j = 0; j < 2; ++j) { unpack8(raw[q][j], v[j]);
#pragma unroll
                for (int e = 0; e < 8; ++e) ss += v[j][e] * v[j][e]; }
            const float rstd = rsqrtf(wave_sum(ss) * (1.f / 1024.f) + 1e-6f);
#pragma unroll
            for (int j = 0; j < 2; ++j) {
                float* dst = p.out + (size_t)(row + q * NGW) * D + 512 * j + 8 * lane;
                *(f32x4*)dst = (f32x4){v[j][0] * rstd * gv[j][0].x, v[j][1] * rstd * gv[j][0].y, v[j][2] * rstd * gv[j][0].z, v[j][3] * rstd * gv[j][0].w};
                *(f32x4*)(dst + 4) = (f32x4){v[j][4] * rstd * gv[j][1].x, v[j][5] * rstd * gv[j][1].y, v[j][6] * rstd * gv[j][1].z, v[j][7] * rstd * gv[j][1].w};
            }
        }
    }
}
constexpr int LDS_BYTES = 148480;

template <class Epi, bool ALIGN = true>
__device__ __forceinline__ void run_gemm(ldsp lds, const bf16* A, const bf16* Bt, int M, int N, int K, int G, int c, const Epi& E) {
    pg8::Gemm g{A, Bt, M, N, K}; pg8::StaticOrder S; S.init(M, N, G, c);
    pg8::gemm_phase<Epi, pg8::StaticOrder, ALIGN, true>(lds, g, S, E);
}

template <unsigned MASK>
__global__ void __launch_bounds__(512, 2) mega_fwd(Params kp) {
    extern __shared__ __attribute__((aligned(16))) unsigned char lds_raw[];
    ldsp lds = (ldsp)lds_raw;
    {
        const int tid = threadIdx.x;
        for (int u = tid; u < 64; u += 512) ((LAS unsigned*)(lds + LDSCTL_OFF))[u] = 0u;
        if (tid < 37) ((LAS unsigned long long*)(lds + LDS_INTAB))[tid] = (unsigned long long)kp.in[tid];
        if (tid == 37) ((LAS unsigned long long*)(lds + LDS_INTAB))[37] = (unsigned long long)kp.out;
        if (tid == 38) ((LAS unsigned long long*)(lds + LDS_INTAB))[38] = (unsigned long long)kp.ws;
        __syncthreads();
        (void)xcd_barrier_post((unsigned*)(kp.ws + WS_CTL), (volatile LAS unsigned*)(lds + LDSCTL_OFF + 64));
    }
#define PH_BEGIN { Ctx p; p.lds = lds; p.ws = (unsigned char*)p.in(38); p.out = (float*)p.in(37); unsigned char* ws = p.ws; int G = gridDim.x, bx = blockIdx.x; asm volatile("" : "+s"(G), "+s"(bx)); (void)ws; (void)G; (void)bx;
#define PH_END   { XcdBarrier bar_; bar_.bar = (unsigned*)(p.ws + WS_CTL); bar_.x = xb_xcc_id(); bar_.st = (volatile LAS unsigned*)(lds + LDSCTL_OFF + 64); xcd_barrier(bar_); } }
#define PH_END_NOBAR }
#define XB_ ((bf16*)(ws + WS_XB))
#define X_ ((float*)(ws + WS_X))
#define SLOT_ ((float*)(ws + WS_SLOT))
#define R3_ ((bf16*)(ws + WS_R3))
#define OB_ ((bf16*)(ws + WS_R3 + (size_t)MP * 1024 * 2))
#define PB_ ((bf16*)(ws + WS_P))
#define DTB_ ((float*)(ws + WS_DT))

    PH_BEGIN
        const int vcu = (G % 8 == 0) ? (bx % 8) * (G / 8) + bx / 8 : bx;
        if constexpr ((MASK & 1u) != 0) { prologue<(MASK >> 24) & 7u>(p, lds, vcu, G); if constexpr ((MASK & 0x4000000u) != 0) prologue_mem(p, vcu, G); }
    PH_END
#pragma unroll 1
    for (int layer = 0; layer < 2; ++layer) {
        PH_BEGIN { EpiSwiglu E{R3_, SLOT_, (MASK & 0x10000000u) ? 0 : 1}; if constexpr ((MASK & 2u) != 0) run_gemm(lds, XB_, (const bf16*)(ws + WS_W1IN + layer * SZ_WIN), MP, 5632, 1024, G, bx, E); }
            if constexpr ((MASK & 0x1000001u) == 0x1000001u) { const int nact = 1430 - (1430 / G) * G; if (nact > 0 && bx >= nact) { __syncthreads(); if (layer == 0) convert_set<1>(p, lds, bx - nact, G - nact); else convert_set<3>(p, lds, bx - nact, G - nact); } } PH_END
        PH_BEGIN if constexpr ((MASK & 16384u) != 0) { EpiResid E{layer == 0 ? p.in(0) : (const float*)nullptr, XB_, SLOT_, 0.5f}; run_gemm(lds, R3_, (const bf16*)(ws + WS_W1OUT + layer * SZ_WOUT), NP, 1024, FF, G, bx, E);
            if constexpr ((MASK & 0x8000000u) != 0) if (bx < 128) { ThinResid T{layer == 0 ? p.in(1) - (size_t)NP * D : (const float*)nullptr, XB_, SLOT_, 0.5f}; thin_gemm(lds, R3_, (const bf16*)(ws + WS_W1OUT + layer * SZ_WOUT), FF, bx, T); } } PH_END
        if (layer == 0) {
            PH_BEGIN if constexpr ((MASK & 32768u) != 0) { { EpiScaleG E{PB_, NAB, 44, DTB_, 32, 32, SLOT_, 1, (const f32x4*)(ws + WS_ROT), 20, 28, 24}; run_gemm(lds, XB_, (const bf16*)(ws + WS_WINAB), MP, NABP, 1024, G, bx, E); }
              { EpiMemKV E{p.out + O_MEMK, p.out + O_MEMV, (bf16*)(ws + WS_KB), (bf16*)(ws + WS_VB), (const float*)(ws + WS_MEMSS)};
                run_gemm(lds, (const bf16*)(ws + WS_MEMB), (const bf16*)(ws + WS_WXKV), 2048, 4096, 1024, G, G - 1 - bx, E); } } PH_END
            PH_BEGIN
            for (int u = bx; u < 256; u += G) if constexpr ((MASK & 4u) != 0) conv_unit(p, u);
            PH_END
            PH_BEGIN
#pragma unroll 1
            for (int st = 0; st < 2; ++st) {
                if ((st == 0) == (((bx >> 3) & 1) != 0)) {
                for (int v = bx; v < 512; v += G) if constexpr ((MASK & 16u) != 0) retS_unit(p, lds, v >> 2, v & 3);
                for (int v = bx; v < 512; v += G) if constexpr ((MASK & 32u) != 0) ssdS_unit(p, lds, v >> 2, v & 3);
                } else {
                for (int u = bx; u < 256; u += G) if constexpr ((MASK & 4u) != 0) { const int bg = (u & 7) * 4 + (u >> 6), hh = (u >> 3) & 7; ssdA_unit(p, lds, bg >> 2, (bg & 3) * 8 + hh); }
                for (int v = bx; v < 256; v += G) if constexpr ((MASK & 8u) != 0) { const int bh = (v & 7) * 4 + (v >> 6); retF_unit(p, lds, bh >> 2, bh & 3, (v >> 3) & 7); }
                }
            }
            PH_END
            PH_BEGIN
            for (int u = bx; u < 512; u += G) if constexpr ((MASK & 64u) != 0) ssdB_unit(p, lds, u >> 6, (u >> 4) & 3, u & 15);
            for (int v = bx; v < 256; v += G) if constexpr ((MASK & 128u) != 0) retN_unit(p, v);
            PH_END
            PH_BEGIN if constexpr ((MASK & 65536u) != 0) { EpiResid E{nullptr, XB_, SLOT_, 1.0f}; run_gemm(lds, R3_, (const bf16*)(ws + WS_WOUTAB), NP, 1024, 4096, G, bx, E);
                if constexpr ((MASK & 0x8000000u) != 0) if (bx < 128) { ThinResid T{nullptr, XB_, SLOT_, 1.0f}; thin_gemm(lds, R3_, (const bf16*)(ws + WS_WOUTAB), 4096, bx, T); } } PH_END
        } else {
            PH_BEGIN if constexpr ((MASK & 2u) != 0) {
                { EpiScaleG E{PB_, NC, 12, DTB_, 8, 8, SLOT_, 0, nullptr, 0, 0, 1 << 30}; run_gemm(lds, XB_, (const bf16*)(ws + WS_WINC), NP, NC, 1024, G, bx, E); }
                if constexpr ((MASK & 0x8000000u) != 0) {
                    for (int t = bx; t < 384; t += G) { ThinScaleLd T{PB_, NC, SLOT_}; thin_gemm_rc(lds, XB_, (const bf16*)(ws + WS_WINC), 1024, NP + 16 * (t & 7), 64 * (t >> 3), 0, T); }
                    for (int t = G - 1 - bx; t < 258; t += G) { ThinGate T{DTB_, SLOT_, NC}; thin_cols16(lds, XB_, (const bf16*)(ws + WS_WINC), 1024, 64 * t, NC, T); }
                } } PH_END
            PH_BEGIN
#pragma unroll 1
            for (int st = 0; st < 2; ++st) {
                if ((st == 0) == (((bx >> 3) & 1) != 0)) {
                for (int v = bx; v < 512; v += G) if constexpr ((MASK & 512u) != 0) mlS_unit(p, lds, v >> 2, v & 3);
                } else {
                for (int u = bx; u < 256; u += G) if constexpr ((MASK & 256u) != 0) mlA_unit(p, lds, u >> 5, (u >> 3) & 3, u & 7);
                }
            }
            PH_END
            PH_BEGIN
            for (int u = bx; u < 512; u += G) if constexpr ((MASK & 1024u) != 0) mlB_unit(p, lds, u >> 6, (u >> 4) & 3, u & 15);
            PH_END
            PH_BEGIN if constexpr ((MASK & 131072u) != 0) { EpiResid E{nullptr, XB_, SLOT_, 1.0f}; run_gemm(lds, R3_, (const bf16*)(ws + WS_WOUTC), NP, 1024, 1024, G, bx, E);
                if constexpr ((MASK & 0x8000000u) != 0) if (bx < 128) { ThinResid T{nullptr, XB_, SLOT_, 1.0f}; thin_gemm(lds, R3_, (const bf16*)(ws + WS_WOUTC), 1024, bx, T); } } PH_END
        }
        PH_BEGIN if constexpr ((MASK & 262144u) != 0) { EpiScaleG E{R3_, 1024, 4, nullptr, 0, 0, SLOT_, 0, nullptr, 0, 0, 1 << 30}; run_gemm(lds, XB_, (const bf16*)(ws + WS_WXQ + layer * SZ_SQ), NP, 1024, 1024, G, bx, E);
            if constexpr ((MASK & 0x8000000u) != 0) if (bx < 128) { ThinScale T{R3_, SLOT_}; thin_gemm(lds, XB_, (const bf16*)(ws + WS_WXQ + layer * SZ_SQ), 1024, bx, T); } } PH_END
        PH_BEGIN
#pragma unroll 1
        for (int st = 0; st < 2; ++st) {
            if ((st == 0) == (((bx >> 3) & 1) != 0)) {
            for (int v = bx; v < 256; v += G) if constexpr ((MASK & 4096u) != 0) xaS2_unit(p, lds, layer, v >> 1, v & 1);
            } else {
            for (int u = bx; u < 512; u += G) if constexpr ((MASK & 2048u) != 0) { const int idx = u >> 3, bh = (u & 7) * 4 + (idx >> 4); xaP_unit(p, lds, layer, bh >> 2, bh & 3, idx & 15); }
            }
        }
        PH_END
        PH_BEGIN if constexpr ((MASK & 524288u) != 0) { EpiResid E{nullptr, XB_, SLOT_, 1.0f}; run_gemm(lds, OB_, (const bf16*)(ws + WS_WXO + layer * SZ_SQ), NP, 1024, 1024, G, bx, E);
            if constexpr ((MASK & 0x8000000u) != 0) if (bx < 128) { ThinResid T{nullptr, XB_, SLOT_, 1.0f}; thin_gemm(lds, OB_, (const bf16*)(ws + WS_WXO + layer * SZ_SQ), 1024, bx, T); } } PH_END
        PH_BEGIN { EpiSwiglu E{R3_, SLOT_, (MASK & 0x10000000u) ? 0 : 1}; if constexpr ((MASK & 2u) != 0) run_gemm(lds, XB_, (const bf16*)(ws + WS_W2IN + layer * SZ_WIN), MP, 5632, 1024, G, bx, E); }
            if constexpr ((MASK & 0x1000001u) == 0x1000001u) { const int nact = 1430 - (1430 / G) * G; if (nact > 0 && bx >= nact) { __syncthreads(); if (layer == 0) convert_set<2>(p, lds, bx - nact, G - nact); else convert_set<4>(p, lds, bx - nact, G - nact); } } PH_END
        PH_BEGIN if constexpr ((MASK & 1048576u) != 0) { EpiResid E{nullptr, XB_, SLOT_, 0.5f}; run_gemm(lds, R3_, (const bf16*)(ws + WS_W2OUT + layer * SZ_WOUT), NP, 1024, FF, G, bx, E);
            if constexpr ((MASK & 0x8000000u) != 0) if (bx < 128) { ThinResid T{nullptr, XB_, SLOT_, 0.5f}; thin_gemm(lds, R3_, (const bf16*)(ws + WS_W2OUT + layer * SZ_WOUT), FF, bx, T); } } PH_END
    }
    PH_BEGIN
        const int vcu = (G % 8 == 0) ? (bx % 8) * (G / 8) + bx / 8 : bx;
        if constexpr ((MASK & 8192u) != 0) final_norm(p, vcu, G);
    PH_END_NOBAR
}

template <unsigned MASK>
static void launch_mega(void* const* d_in, void* d_out, void* d_ws, size_t ws_size, hipStream_t stream) {
    static int g_grid = 0;
    if (g_grid == 0) {
        int dev = 0, cus = 0;
        if (ws_size < WS_END || hipGetDevice(&dev) != hipSuccess || hipDeviceGetAttribute(&cus, hipDeviceAttributeMultiprocessorCount, dev) != hipSuccess ||
            hipFuncSetAttribute((const void*)mega_fwd<MASK>, hipFuncAttributeMaxDynamicSharedMemorySize, LDS_BYTES) != hipSuccess) {
            fprintf(stderr, "kernel_launch: setup failed (ws %zu, need %zu)\n", ws_size, (size_t)WS_END); g_grid = -1; return; }
        int per_cu = 0;
        if (hipOccupancyMaxActiveBlocksPerMultiprocessor(&per_cu, (const void*)mega_fwd<MASK>, 512, LDS_BYTES) != hipSuccess || per_cu < 1) fprintf(stderr, "kernel_launch: occupancy query says %d\n", per_cu);
        (void)hipGetLastError();
        g_grid = cus;
    }
    if (g_grid < 0) return;
    (void)hipMemsetAsync((char*)d_ws + WS_CTL, 0, 16384, stream);
    Params p{};
    for (int i = 0; i < 37; ++i) p.in[i] = (const float*)d_in[i];
    p.out = (float*)d_out; p.ws = (unsigned char*)d_ws;
    hipLaunchKernelGGL(mega_fwd<MASK>, dim3(g_grid), dim3(512), LDS_BYTES, stream, p);
}
}
extern "C" void kernel_launch(void* const* d_in, const int* in_sizes, int n_in, void* d_out, int out_size, void* d_ws, size_t ws_size, hipStream_t stream) {
    mk::launch_mega<0x1fffffffu>(d_in, d_out, d_ws, ws_size, stream);
}
```
